# Optimizing an MI355X kernel written in HIP

```python
import math
import jax, jax.numpy as jnp
from jax import lax
import numpy as np

D_MODEL = 1024
BATCH = 8
SEQ = 4096
DEPTH = 2

D_CONV = 256
CONV_GROUPS = 4
CONV_WIDTH = 3
D_GMLP = 256
GMLP_HEADS = 4
GMLP_HEAD_DIM = D_GMLP // GMLP_HEADS
GMLP_CHUNK = 128
HEAD_DIM = 64
NSA_HEADS = 8
NSA_KV_HEADS = 2
NSA_GROUP = NSA_HEADS // NSA_KV_HEADS
D_NSA = NSA_HEADS * HEAD_DIM
D_KV = NSA_KV_HEADS * HEAD_DIM
D_MIX = D_CONV + D_GMLP + D_NSA
D_IN_PROJ = 3 * D_CONV + 2 * D_GMLP + D_NSA + 6 * D_KV + 3 * NSA_HEADS
CMP_LEN = 32
CMP_STRIDE = 16
CMP_HIDDEN = 128
SEL_BLOCK = 64
N_SELECT = 16
WINDOW = 512
Q_BLOCK = 128
D_FF = 2816
ALPHA = (2 * DEPTH) ** 0.25
BETA = (8 * DEPTH) ** -0.25
LN_EPS = 1e-5
NEG = -1e30

kernel_name = "hymba_style_conv_gmlp_nsa_macaron_deepnorm"


def layer_norm(x, g, b):
    xf = x.astype(jnp.float32)
    mu = jnp.mean(xf, axis=-1, keepdims=True)
    var = jnp.mean(jnp.square(xf - mu), axis=-1, keepdims=True)
    return ((xf - mu) * lax.rsqrt(var + LN_EPS) * g + b).astype(x.dtype)


def swiglu(x, w_gate, w_up, w_down):
    return (jax.nn.silu(x @ w_gate) * (x @ w_up)) @ w_down


def masked_softmax(s, mask):
    p = jax.nn.softmax(jnp.where(mask, s.astype(jnp.float32), NEG), axis=-1)
    return p * mask


def short_conv(h, b_gate, c_gate, w_conv):
    z = c_gate * h
    y = lax.conv_general_dilated(
        z, w_conv[:, None, :], window_strides=(1,),
        padding=[(CONV_WIDTH - 1, 0)],
        dimension_numbers=("NWC", "WIO", "NWC"),
        feature_group_count=D_CONV)
    return b_gate * y


def gmlp_spatial(uv, ln_g, ln_b, w_s, b_s):
    bn, s = uv.shape[:2]
    z = jax.nn.gelu(uv)
    u, v = z[..., :D_GMLP], z[..., D_GMLP:]
    v = layer_norm(v, ln_g, ln_b)
    v = v.reshape(bn, s // GMLP_CHUNK, GMLP_CHUNK, GMLP_HEADS, GMLP_HEAD_DIM)
    tril = jnp.tril(jnp.ones((GMLP_CHUNK, GMLP_CHUNK), dtype=bool))
    w = jnp.where(tril[None], w_s, 0.0)
    sv = jnp.einsum("hpq,bcqhd->bcphd", w, v) + b_s.T[:, :, None]
    return u * sv.reshape(bn, s, D_GMLP)


def compress_kv(k, pe, w1, b1, w2):
    s = k.shape[1]
    n_cmp = (s - CMP_LEN) // CMP_STRIDE + 1
    idx = np.arange(n_cmp)[:, None] * CMP_STRIDE + np.arange(CMP_LEN)[None, :]
    kb = k[:, idx]
    h = jax.nn.gelu(jnp.einsum("bnlgd,ldf->bngf", kb + pe[:, None, :], w1) + b1)
    return jnp.einsum("bngf,fe->bnge", h, w2)


def cmp_to_sel_overlap(n_cmp, n_blk):
    st = np.arange(n_cmp) * CMP_STRIDE
    bs = np.arange(n_blk) * SEL_BLOCK
    ov = np.minimum(st[:, None] + CMP_LEN, bs[None, :] + SEL_BLOCK) - np.maximum(st[:, None], bs[None, :])
    return jnp.asarray(np.clip(ov, 0, None) / CMP_LEN, dtype=jnp.float32)


def nsa_attention(q, k_cmp, v_cmp, k_slc, v_slc, k_win, v_win, gate_logits,
                  ck_pe, ck_w1, ck_b1, ck_w2, cv_pe, cv_w1, cv_b1, cv_w2):
    bn, s = q.shape[:2]
    G, R, dh = NSA_KV_HEADS, NSA_GROUP, HEAD_DIM
    q = q.reshape(bn, s, G, R, dh)
    k_cmp, v_cmp, k_slc, v_slc, k_win, v_win = [
        a.reshape(bn, s, G, dh) for a in (k_cmp, v_cmp, k_slc, v_slc, k_win, v_win)]
    scale = dh ** -0.5
    n_cmp = (s - CMP_LEN) // CMP_STRIDE + 1
    n_blk = s // SEL_BLOCK
    n_sel = min(N_SELECT, n_blk)
    t = jnp.arange(s)

    kc = compress_kv(k_cmp, ck_pe, ck_w1, ck_b1, ck_w2)
    vc = compress_kv(v_cmp, cv_pe, cv_w1, cv_b1, cv_w2)
    sc = jnp.einsum("bsgrd,bngd->bgrsn", q, kc) * scale
    cmp_end = jnp.arange(n_cmp) * CMP_STRIDE + CMP_LEN - 1
    pc = masked_softmax(sc, cmp_end[None, :] <= t[:, None])
    o_cmp = jnp.einsum("bgrsn,bngd->bsgrd", pc.astype(vc.dtype), vc)

    imp = jnp.einsum("bgrsn,nj->bgsj", pc, cmp_to_sel_overlap(n_cmp, n_blk))
    j = jnp.arange(n_blk)
    cur = (t // SEL_BLOCK)[:, None]
    valid = j[None, :] <= cur
    forced = (j[None, :] == 0) | (j[None, :] == cur) | (j[None, :] == cur - 1)
    score = jnp.where(valid, imp, NEG)
    score = jnp.where(forced, -NEG, score)
    _, sel = lax.top_k(score, n_sel)

    ks_blk = k_slc.reshape(bn, n_blk, SEL_BLOCK, G, dh).transpose(0, 3, 1, 2, 4)
    vs_blk = v_slc.reshape(bn, n_blk, SEL_BLOCK, G, dh).transpose(0, 3, 1, 2, 4)
    kw_pad = jnp.pad(k_win, ((0, 0), (WINDOW, 0), (0, 0), (0, 0)))
    vw_pad = jnp.pad(v_win, ((0, 0), (WINDOW, 0), (0, 0), (0, 0)))
    bi = jnp.arange(bn)[:, None, None, None]
    gi = jnp.arange(G)[None, :, None, None]

    def query_block(i):
        s0 = i * Q_BLOCK
        qb = lax.dynamic_slice_in_dim(q, s0, Q_BLOCK, axis=1)
        tq = s0 + jnp.arange(Q_BLOCK)
        idx = lax.dynamic_slice_in_dim(sel, s0, Q_BLOCK, axis=2)
        kg = ks_blk[bi, gi, idx]
        vg = vs_blk[bi, gi, idx]
        ss = jnp.einsum("bqgrd,bgqnkd->bgrqnk", qb, kg) * scale
        kpos = idx[..., None] * SEL_BLOCK + jnp.arange(SEL_BLOCK)
        ms = (kpos <= tq[None, None, :, None, None])[:, :, None]
        ps = masked_softmax(ss.reshape(bn, G, R, Q_BLOCK, n_sel * SEL_BLOCK),
                            ms.reshape(bn, G, 1, Q_BLOCK, n_sel * SEL_BLOCK))
        ps = ps.reshape(bn, G, R, Q_BLOCK, n_sel, SEL_BLOCK).astype(vg.dtype)
        o_s = jnp.einsum("bgrqnk,bgqnkd->bqgrd", ps, vg)
        kw = lax.dynamic_slice_in_dim(kw_pad, s0, Q_BLOCK + WINDOW, axis=1)
        vw = lax.dynamic_slice_in_dim(vw_pad, s0, Q_BLOCK + WINDOW, axis=1)
        kp = s0 - WINDOW + jnp.arange(Q_BLOCK + WINDOW)
        dist = tq[:, None] - kp[None, :]
        mw = (dist >= 0) & (dist < WINDOW) & (kp[None, :] >= 0)
        sw = jnp.einsum("bqgrd,bkgd->bgrqk", qb, kw) * scale
        pw = masked_softmax(sw, mw).astype(vw.dtype)
        o_w = jnp.einsum("bgrqk,bkgd->bqgrd", pw, vw)
        return o_s, o_w

    o_s, o_w = lax.map(query_block, jnp.arange(s // Q_BLOCK))
    o_s = o_s.transpose(1, 0, 2, 3, 4, 5).reshape(bn, s, G, R, dh)
    o_w = o_w.transpose(1, 0, 2, 3, 4, 5).reshape(bn, s, G, R, dh)

    g = jax.nn.sigmoid(gate_logits).reshape(bn, s, G, R, 3)
    o = g[..., 0, None] * o_cmp + g[..., 1, None] * o_s + g[..., 2, None] * o_w
    return o.reshape(bn, s, D_NSA)


def setup_inputs(seed: int = 0) -> dict:
    key = jax.random.key(seed)
    keys = iter(jax.random.split(key, 48))
    L = DEPTH

    def nrm(shape, scale):
        return scale * jax.random.normal(next(keys), shape, jnp.float32)

    def gain(shape):
        return 1.0 + nrm(shape, 0.01)

    inp = {}
    inp["x"] = nrm((BATCH, SEQ, D_MODEL), 1.0)
    inp["ffn1_gate"] = nrm((L, D_MODEL, D_FF), D_MODEL ** -0.5)
    inp["ffn1_up"] = nrm((L, D_MODEL, D_FF), D_MODEL ** -0.5)
    inp["ffn1_down"] = nrm((L, D_FF, D_MODEL), BETA * D_FF ** -0.5)
    inp["ln1_g"] = gain((L, D_MODEL))
    inp["ln1_b"] = nrm((L, D_MODEL), 0.01)
    inp["w_in"] = nrm((L, D_MODEL, D_IN_PROJ), D_MODEL ** -0.5)
    inp["conv_w"] = nrm((L, CONV_WIDTH, D_CONV), CONV_WIDTH ** -0.5)
    inp["gmlp_ln_g"] = gain((L, D_GMLP))
    inp["gmlp_ln_b"] = nrm((L, D_GMLP), 0.01)
    inp["gmlp_w"] = nrm((L, GMLP_HEADS, GMLP_CHUNK, GMLP_CHUNK), GMLP_CHUNK ** -0.5)
    inp["gmlp_b"] = gain((L, GMLP_HEADS, GMLP_CHUNK))
    inp["ck_pe"] = nrm((L, CMP_LEN, HEAD_DIM), 0.1)
    inp["ck_w1"] = nrm((L, CMP_LEN, HEAD_DIM, CMP_HIDDEN), (CMP_LEN * HEAD_DIM) ** -0.5)
    inp["ck_b1"] = nrm((L, CMP_HIDDEN), 0.01)
    inp["ck_w2"] = nrm((L, CMP_HIDDEN, HEAD_DIM), CMP_HIDDEN ** -0.5)
    inp["cv_pe"] = nrm((L, CMP_LEN, HEAD_DIM), 0.1)
    inp["cv_w1"] = nrm((L, CMP_LEN, HEAD_DIM, CMP_HIDDEN), (CMP_LEN * HEAD_DIM) ** -0.5)
    inp["cv_b1"] = nrm((L, CMP_HIDDEN), 0.01)
    inp["cv_w2"] = nrm((L, CMP_HIDDEN, HEAD_DIM), CMP_HIDDEN ** -0.5)
    inp["w_out"] = nrm((L, D_MIX, D_MODEL), BETA * D_MIX ** -0.5)
    inp["ln2_g"] = gain((L, D_MODEL))
    inp["ln2_b"] = nrm((L, D_MODEL), 0.01)
    inp["ffn2_gate"] = nrm((L, D_MODEL, D_FF), D_MODEL ** -0.5)
    inp["ffn2_up"] = nrm((L, D_MODEL, D_FF), D_MODEL ** -0.5)
    inp["ffn2_down"] = nrm((L, D_FF, D_MODEL), BETA * D_FF ** -0.5)
    inp["ln3_g"] = gain((L, D_MODEL))
    inp["ln3_b"] = nrm((L, D_MODEL), 0.01)
    return inp


def reference(x, ffn1_gate, ffn1_up, ffn1_down, ln1_g, ln1_b, w_in, conv_w,
              gmlp_ln_g, gmlp_ln_b, gmlp_w, gmlp_b,
              ck_pe, ck_w1, ck_b1, ck_w2, cv_pe, cv_w1, cv_b1, cv_w2,
              w_out, ln2_g, ln2_b, ffn2_gate, ffn2_up, ffn2_down, ln3_g, ln3_b):
    split_points = list(np.cumsum([D_CONV, D_CONV, D_CONV, 2 * D_GMLP, D_NSA,
                                   D_KV, D_KV, D_KV, D_KV, D_KV, D_KV]))
    split_points = [int(p) for p in split_points]
    for l in range(DEPTH):
        x = layer_norm(ALPHA * x + 0.5 * swiglu(x, ffn1_gate[l], ffn1_up[l], ffn1_down[l]),
                       ln1_g[l], ln1_b[l])
        proj = x @ w_in[l]
        (h_a, b_a, c_a, uv, q, kc, vc, ksl, vsl, kw, vw, gl) = jnp.split(proj, split_points, axis=-1)
        y_a = short_conv(h_a, b_a, c_a, conv_w[l])
        y_b = gmlp_spatial(uv, gmlp_ln_g[l], gmlp_ln_b[l], gmlp_w[l], gmlp_b[l])
        y_c = nsa_attention(q, kc, vc, ksl, vsl, kw, vw, gl,
                            ck_pe[l], ck_w1[l], ck_b1[l], ck_w2[l],
                            cv_pe[l], cv_w1[l], cv_b1[l], cv_w2[l])
        mix = jnp.concatenate([y_a, y_b, y_c], axis=-1) @ w_out[l]
        x = layer_norm(ALPHA * x + mix, ln2_g[l], ln2_b[l])
        x = layer_norm(ALPHA * x + 0.5 * swiglu(x, ffn2_gate[l], ffn2_up[l], ffn2_down[l]),
                       ln3_g[l], ln3_b[l])
    return x
```

```cpp
#include <hip/hip_runtime.h>
#include <hip/hip_cooperative_groups.h>
#include <cstdio>
#include <cstdint>
namespace cg = cooperative_groups;

typedef unsigned short bf16_t;
typedef short bf16x8 __attribute__((ext_vector_type(8)));
typedef float f32x4 __attribute__((ext_vector_type(4)));
typedef unsigned u32x4 __attribute__((ext_vector_type(4)));
typedef unsigned u32x2 __attribute__((ext_vector_type(2)));

#ifndef MK_DSEL
#define MK_DSEL 4
#endif
#ifndef MK_DCOL
#define MK_DCOL 512
#endif
#ifndef MK_STOP
#define MK_STOP 1000
#endif
#ifndef MK_MULTI
#define MK_MULTI 0
#endif

constexpr int BATCH = 8, SEQ = 4096, DM = 1024, TOK = BATCH * SEQ, DFF = 2816, NPROJ = 2816, NPROJ_SRC = 2584;
constexpr int C_HA = 0, C_BA = 256, C_CA = 512, C_U = 768, C_V = 1024, C_Q = 1280, C_KC = 1792, C_VC = 1920, C_KS = 2048, C_VS = 2176,
              C_KW = 2304, C_VW = 2432, C_GL = 2560;
constexpr float ALPHA = 1.41421356237f;
constexpr float LN_EPS = 1e-5f;
constexpr int XB_ST_OFF = 4 * 16384 + 65536 + 512;
constexpr int LDS_BYTES = XB_ST_OFF + 16;

constexpr size_t SZ_GU = (size_t)5632 * 1024 * 2, SZ_DN = (size_t)1024 * 2816 * 2, SZ_IN = (size_t)2816 * 1024 * 2, SZ_OUT = (size_t)1024 * 1024 * 2;
constexpr size_t WS_GU = 0;
constexpr size_t WS_DN = WS_GU + 4 * SZ_GU;
constexpr size_t WS_IN = WS_DN + 4 * SZ_DN;
constexpr size_t WS_OUT = WS_IN + 2 * SZ_IN;
constexpr size_t WS_GM = WS_OUT + 2 * SZ_OUT;
constexpr size_t WS_C1 = WS_GM + (size_t)2 * 4 * 128 * 128 * 2;
constexpr size_t WS_C2 = WS_C1 + (size_t)2 * 2 * 128 * 2048 * 2;
constexpr size_t WS_B1 = WS_C2 + (size_t)2 * 2 * 64 * 128 * 2;
constexpr size_t WS_XB = WS_B1 + 4096;
constexpr size_t WS_HP = WS_XB + (size_t)TOK * 1024 * 2;
constexpr size_t WS_MIX = WS_HP + (size_t)TOK * 2816 * 2;
constexpr size_t WS_KCMP = WS_MIX + (size_t)TOK * 1024 * 2;
constexpr size_t WS_VT = WS_KCMP + (size_t)2 * 16 * 256 * 64 * 2;
constexpr size_t WS_BAR = WS_VT + (size_t)2 * 16 * 64 * SEQ * 2;
constexpr size_t WS_END = WS_BAR + 16384;

struct TJob { const float* src; bf16_t* dst; int K, N, Nsrc, rowMul, rowOff, tileStart, perm, pad; };
constexpr int NJOBS = 24;
struct Params {
    const float* in[28];
    float* out;
    unsigned char* ws;
    int ntiles_total;
    int ph_lo, ph_hi, pad0;
};
struct JobTab { TJob jobs[NJOBS]; };
__device__ __forceinline__ unsigned char* wsp(const Params& p) { long z; asm volatile("s_mov_b64 %0, 0" : "=s"(z)); return p.ws + z; }
__device__ __forceinline__ float* outp(const Params& p) { long z; asm volatile("s_mov_b64 %0, 0" : "=s"(z)); return p.out + z; }
__device__ __forceinline__ const float* pin(const Params& p, int k) { int z; asm volatile("s_mov_b32 %0, 0" : "=s"(z)); return p.in[k + z]; }

typedef float f32x2_t __attribute__((ext_vector_type(2)));
typedef __bf16 bf16x2_t __attribute__((ext_vector_type(2)));
__device__ __forceinline__ unsigned cvt_pk_bf16(float lo, float hi) { f32x2_t v = {lo, hi}; bf16x2_t b = __builtin_convertvector(v, bf16x2_t); return __builtin_bit_cast(unsigned, b); }
__device__ __forceinline__ bf16_t f2bf(float f) { return (bf16_t)(cvt_pk_bf16(f, 0.f) & 0xffffu); }
__device__ __forceinline__ float bf2f(unsigned h) { return __uint_as_float(h << 16); }
__device__ __forceinline__ float bflo(unsigned w) { return __uint_as_float(w << 16); }
__device__ __forceinline__ float bfhi(unsigned w) { return __uint_as_float(w & 0xffff0000u); }
__device__ __forceinline__ float fast_rcp(float x) { return __builtin_amdgcn_rcpf(x); }
__device__ __forceinline__ float fexp2(float x) { return __builtin_amdgcn_exp2f(x); }
__device__ __forceinline__ float sigmoidf_(float x) { return fast_rcp(1.f + fexp2(-1.44269504089f * x)); }
__device__ __forceinline__ float siluf_(float x) { return x * sigmoidf_(x); }
__device__ __forceinline__ float gelu_tanh(float x) { const float u = 1.59576912161f * (x + 0.044715f * x * x * x); return x * sigmoidf_(u); }
__device__ __forceinline__ float shx(float v, int mask, int lane) { return __int_as_float(__builtin_amdgcn_ds_bpermute((lane ^ mask) << 2, __float_as_int(v))); }
__device__ __forceinline__ float wave_sum(float v, int lane) {
#pragma unroll
    for (int o = 1; o < 64; o <<= 1) v += shx(v, o, lane);
    return v;
}

extern __shared__ __attribute__((aligned(16))) unsigned char dyn_lds[];
__device__ __forceinline__ int bidx() { int b = blockIdx.x; asm volatile("" : "+s"(b)); return b; }
__device__ __forceinline__ int gdim() { int g = gridDim.x; asm volatile("" : "+s"(g)); return g; }
__device__ __forceinline__ int tidx(int wv) { int lane; asm volatile("v_mbcnt_lo_u32_b32 %0, -1, 0\n\tv_mbcnt_hi_u32_b32 %0, -1, %0" : "=v"(lane)); return wv * 64 + lane; }

struct TTile { f32x4 v0, v1; };
__device__ __forceinline__ void transpose_load(const TJob& jb, int tile, int tid, TTile& r) {
    const int ntn = jb.N >> 6, tk = tile / ntn, tn = tile - tk * ntn, k0 = tk * 64, n0 = tn * 64;
    const int k = tid >> 4, n4 = (tid & 15) * 4;
    r.v0 = (f32x4){0.f, 0.f, 0.f, 0.f}; r.v1 = r.v0;
    if (n0 + n4 < jb.Nsrc) { r.v0 = *(const f32x4*)(jb.src + (size_t)(k0 + k) * jb.Nsrc + n0 + n4); r.v1 = *(const f32x4*)(jb.src + (size_t)(k0 + k + 32) * jb.Nsrc + n0 + n4); }
}
__device__ __forceinline__ void transpose_store(const TJob& jb, int tile, int tid, const TTile& r) {
    bf16_t* s = (bf16_t*)dyn_lds;
    const int ntn = jb.N >> 6, tk = tile / ntn, tn = tile - tk * ntn, k0 = tk * 64, n0 = tn * 64;
    {
        const int k = tid >> 4, n4 = (tid & 15) * 4;
        s[(n4 + 0) * 72 + k] = f2bf(r.v0[0]); s[(n4 + 1) * 72 + k] = f2bf(r.v0[1]); s[(n4 + 2) * 72 + k] = f2bf(r.v0[2]); s[(n4 + 3) * 72 + k] = f2bf(r.v0[3]);
        s[(n4 + 0) * 72 + k + 32] = f2bf(r.v1[0]); s[(n4 + 1) * 72 + k + 32] = f2bf(r.v1[1]); s[(n4 + 2) * 72 + k + 32] = f2bf(r.v1[2]); s[(n4 + 3) * 72 + k + 32] = f2bf(r.v1[3]);
    }
    __syncthreads();
    {
        const int n = tid >> 3, k8 = (tid & 7) * 8;
        const u32x4 w = *(const u32x4*)(s + n * 72 + k8);
        const int ng = n0 + n; int c128 = ng & 127;
        if (jb.perm) { const int c32 = c128 & 31; c128 = (c128 & 96) + ((c32 >> 2) & 1) * 16 + (c32 >> 3) * 4 + (c32 & 3); }
        const int drow = (ng >> 7) * jb.rowMul + c128 + jb.rowOff;
        *(u32x4*)(jb.dst + (size_t)drow * jb.K + k0 + k8) = w;
    }
    __syncthreads();
}

__device__ __forceinline__ void phase_prologue(const Params& p, const JobTab& jt, int wv) {
    const int tid = tidx(wv), G = gdim();
    {
        auto find_job = [&](int t) { int j = 0;
#pragma unroll 1
            for (int q = 1; q < NJOBS; ++q) if (t >= jt.jobs[q].tileStart) j = q;
            return j; };
        int t = bidx();
        TTile cur, nxt;
        int j = 0;
        if (t < p.ntiles_total) { j = find_job(t); transpose_load(jt.jobs[j], t - jt.jobs[j].tileStart, tid, cur); }
        while (t < p.ntiles_total) {
            const int tn = t + G; int jn = 0;
            if (tn < p.ntiles_total) { jn = find_job(tn); transpose_load(jt.jobs[jn], tn - jt.jobs[jn].tileStart, tid, nxt); }
            transpose_store(jt.jobs[j], t - jt.jobs[j].tileStart, tid, cur);
            cur = nxt; t = tn; j = jn;
        }
    }
    {
        const float* x = pin(p, 0); bf16_t* xb = (bf16_t*)(wsp(p) + WS_XB);
        const size_t n8 = (size_t)TOK * DM / 8;
        for (size_t i = (size_t)bidx() * 512 + tid; i < n8; i += (size_t)G * 512) {
            const f32x4 a = *(const f32x4*)(x + i * 8), b = *(const f32x4*)(x + i * 8 + 4);
            u32x4 w; w.x = cvt_pk_bf16(a[0], a[1]); w.y = cvt_pk_bf16(a[2], a[3]); w.z = cvt_pk_bf16(b[0], b[1]); w.w = cvt_pk_bf16(b[2], b[3]);
            *(u32x4*)(xb + i * 8) = w;
        }
    }
    {
        const float* w = pin(p, 10); bf16_t* o = (bf16_t*)(wsp(p) + WS_GM);
        for (int i = bidx() * 512 + tid; i < 2 * 4 * 128 * 128; i += G * 512) { const int q = i & 127, pp = (i >> 7) & 127; o[i] = (q <= pp) ? f2bf(w[i]) : (bf16_t)0; }
    }
    if (bidx() < 4) {
        const int l = bidx() >> 1, kv = bidx() & 1;
        const float* pe = pin(p, kv ? 16 : 12) + (size_t)l * 2048;
        const float* w1 = pin(p, kv ? 17 : 13) + (size_t)l * 2048 * 128;
        const float* b1 = pin(p, kv ? 18 : 14) + (size_t)l * 128;
        float* red = (float*)dyn_lds;
        const int f = tid & 127, part = tid >> 7;
        float s = 0.f;
        for (int k = part * 512; k < part * 512 + 512; ++k) s += pe[k] * w1[(size_t)k * 128 + f];
        red[tid] = s;
        __syncthreads();
        if (tid < 128) ((float*)(wsp(p) + WS_B1))[(l * 2 + kv) * 128 + tid] = b1[tid] + red[tid] + red[tid + 128] + red[tid + 256] + red[tid + 384];
        __syncthreads();
    }
}

namespace gm {
constexpr int BM = 256, BK = 64, HALF = 128, NXCD = 8, WGM = 8, HT = HALF * BK;
__device__ __forceinline__ int lds_byte(int r, int c) { int st = (r >> 4) * 2 + (c >> 5), rr = r & 15, cc = c & 31, ob = rr * 64 + cc * 2; return st * 1024 + (ob ^ (((ob >> 9) & 1) << 5)); }
__device__ __forceinline__ void stage_rc(int b, int& R, int& C) { int st = b / 1024, sb = b % 1024, swz = sb ^ (((sb >> 9) & 1) << 5); R = (st >> 1) * 16 + swz / 64; C = (st & 1) * 32 + (swz % 64) / 2; }

struct EpiSwiglu {
    bf16_t* H;
    __device__ __forceinline__ void operator()(const f32x4 (&acc)[2][2][4][2], int brow, int pn, int wr, int wc, int fr, int fq) const {
#pragma unroll
        for (int ai = 0; ai < 2; ++ai)
#pragma unroll
            for (int m = 0; m < 4; ++m) {
                const int row = brow + ai * HALF + wr * 64 + m * 16 + fr;
                const f32x4 g0 = acc[ai][0][m][0], u0 = acc[ai][1][m][0], g1 = acc[ai][0][m][1], u1 = acc[ai][1][m][1];
                u32x4 w;
                w.x = cvt_pk_bf16(siluf_(g0[0]) * u0[0], siluf_(g0[1]) * u0[1]); w.y = cvt_pk_bf16(siluf_(g0[2]) * u0[2], siluf_(g0[3]) * u0[3]);
                w.z = cvt_pk_bf16(siluf_(g1[0]) * u1[0], siluf_(g1[1]) * u1[1]); w.w = cvt_pk_bf16(siluf_(g1[2]) * u1[2], siluf_(g1[3]) * u1[3]);
                *(u32x4*)(H + (size_t)row * DFF + pn * 128 + wc * 32 + fq * 8) = w;
            }
    }
};
struct EpiResid {
    const bf16_t* res; float* out; float sa, sb;
    __device__ __forceinline__ void operator()(const f32x4 (&acc)[2][2][4][2], int brow, int pn, int wr, int wc, int fr, int fq) const {
#pragma unroll
        for (int ai = 0; ai < 2; ++ai)
#pragma unroll
            for (int m = 0; m < 4; ++m) {
                const int row = brow + ai * HALF + wr * 64 + m * 16 + fr;
#pragma unroll
                for (int bj = 0; bj < 2; ++bj) {
                    const size_t off = (size_t)row * DM + pn * BM + bj * HALF + wc * 32 + fq * 8;
                    const u32x4 rw = *(const u32x4*)(res + off);
                    const f32x4 r0 = {bflo(rw.x), bfhi(rw.x), bflo(rw.y), bfhi(rw.y)}, r1 = {bflo(rw.z), bfhi(rw.z), bflo(rw.w), bfhi(rw.w)};
                    *(f32x4*)(out + off) = r0 * sa + acc[ai][bj][m][0] * sb;
                    *(f32x4*)(out + off + 4) = r1 * sa + acc[ai][bj][m][1] * sb;
                }
            }
    }
};
struct EpiBf16 {
    bf16_t* O; int ld;
    __device__ __forceinline__ void operator()(const f32x4 (&acc)[2][2][4][2], int brow, int pn, int wr, int wc, int fr, int fq) const {
#pragma unroll
        for (int ai = 0; ai < 2; ++ai)
#pragma unroll
            for (int m = 0; m < 4; ++m) {
                const int row = brow + ai * HALF + wr * 64 + m * 16 + fr;
#pragma unroll
                for (int bj = 0; bj < 2; ++bj) {
                    const f32x4 v0 = acc[ai][bj][m][0], v1 = acc[ai][bj][m][1];
                    u32x4 w; w.x = cvt_pk_bf16(v0[0], v0[1]); w.y = cvt_pk_bf16(v0[2], v0[3]); w.z = cvt_pk_bf16(v1[0], v1[1]); w.w = cvt_pk_bf16(v1[2], v1[3]);
                    *(u32x4*)(O + (size_t)row * ld + pn * BM + bj * HALF + wc * 32 + fq * 8) = w;
                }
            }
    }
};

#define SA(b, h) (shm + ((b) * 2 + (h)) * HT)
#define SB(b, h) (shm + (4 + (b) * 2 + (h)) * HT)
#define STAGE(P, BASE, br, kt) do { const bf16_t* _ub = (BASE) + __builtin_amdgcn_readfirstlane((br) * K + (kt) * BK); \
    __builtin_amdgcn_global_load_lds((const unsigned*)((const char*)_ub + voff0), (unsigned*)((char*)(P) + tid16), 16, 0, 0); \
    __builtin_amdgcn_global_load_lds((const unsigned*)((const char*)_ub + voff1), (unsigned*)((char*)(P) + tid16 + 8192), 16, 0, 0); } while (0)
#define LDA(dst, b, h) for (int m = 0; m < 4; ++m) for (int k = 0; k < 2; ++k) \
    dst[m][k] = *reinterpret_cast<const bf16x8*>((char*)SA(b, h) + lds_byte(wr * 64 + m * 16 + fr, k * 32 + fq * 8))
#define LDB(dst, b, h) for (int n = 0; n < 2; ++n) for (int k = 0; k < 2; ++k) \
    dst[n][k] = *reinterpret_cast<const bf16x8*>((char*)SB(b, h) + lds_byte(wc * 32 + n * 16 + fr, k * 32 + fq * 8))
#define MMA(ai, bj, At, Bt_) do { __builtin_amdgcn_s_setprio(1); \
    for (int m = 0; m < 4; ++m) for (int n = 0; n < 2; ++n) for (int k = 0; k < 2; ++k) \
      acc[ai][bj][m][n] = __builtin_amdgcn_mfma_f32_16x16x32_bf16(Bt_[n][k], At[m][k], acc[ai][bj][m][n], 0, 0, 0); \
    __builtin_amdgcn_s_setprio(0); } while (0)
#define WAIT_V(n) asm volatile("s_waitcnt vmcnt(" #n ")" ::: "memory")
#define WAIT_L(n) asm volatile("s_waitcnt lgkmcnt(" #n ")" ::: "memory")
#define BAR __builtin_amdgcn_s_barrier()
#define SCHED __builtin_amdgcn_sched_barrier(0)

template <int N, int K, class Epi>
__device__ __forceinline__ void gemm_phase(const bf16_t* __restrict__ A, const bf16_t* __restrict__ Bt, const Epi& epi, int wv) {
    constexpr int M = TOK;
    bf16_t* shm = (bf16_t*)dyn_lds;
    constexpr int nM = M / BM, nN = N / BM, nwg = nM * nN; const int G = gdim();
    static_assert(nwg % NXCD == 0 && nM % WGM == 0, "tile map assumes these");
    const int tidg = tidx(wv);
    const int wid = tidg >> 6, lane = tidg & 63, wr = wid >> 2, wc = wid & 3, fr = lane & 15, fq = lane >> 4;
    constexpr int nt = K / BK;
    const int tid16 = tidg * 16;
    unsigned voff0, voff1;
    { int _r, _c; stage_rc(tid16, _r, _c); voff0 = (unsigned)(_r * K + _c) * 2u; stage_rc(tid16 + 8192, _r, _c); voff1 = (unsigned)(_r * K + _c) * 2u; }
    long L = bidx();
    if (L >= nwg) return;
    int brow, bcol, pn;
#define TILE_COORDS() do { int wgid = (int)L; wgid = (wgid % NXCD) * (nwg / NXCD) + wgid / NXCD; \
        constexpr int nig = WGM * nN; const int gid = wgid / nig, wl = wgid - gid * nig; \
        const int pm = gid * WGM + (wl % WGM); pn = wl / WGM; brow = pm * BM; bcol = pn * BM; } while (0)
    TILE_COORDS();
    STAGE(SB(0, 0), Bt, bcol, 0); STAGE(SA(0, 0), A, brow, 0);
    STAGE(SB(0, 1), Bt, bcol + HALF, 0); STAGE(SA(0, 1), A, brow + HALF, 0);
#pragma unroll 1
    for (;;) {
        f32x4 acc[2][2][4][2] = {};
        bf16x8 At[4][2], B0[2][2], B1[2][2];
        if (wr == 1) BAR;
        WAIT_V(4); BAR;
        STAGE(SB(1, 0), Bt, bcol, 1); STAGE(SA(1, 0), A, brow, 1); STAGE(SB(1, 1), Bt, bcol + HALF, 1);
        WAIT_V(6); BAR;
#pragma unroll 1
        for (int t = 0; t < nt - 2; t += 2) {
            LDB(B0, 0, 0); SCHED; LDA(At, 0, 0); STAGE(SA(1, 1), A, brow + HALF, t + 1);
            WAIT_L(8); BAR; WAIT_L(0); MMA(0, 0, At, B0); BAR; SCHED;
            LDB(B1, 0, 1); STAGE(SB(0, 0), Bt, bcol, t + 2);
            BAR; WAIT_L(0); MMA(0, 1, At, B1); BAR;
            LDA(At, 0, 1); STAGE(SA(0, 0), A, brow, t + 2);
            BAR; WAIT_L(0); MMA(1, 0, At, B0); BAR; SCHED;
            STAGE(SB(0, 1), Bt, bcol + HALF, t + 2);
            WAIT_V(6); BAR; MMA(1, 1, At, B1); BAR;
            LDB(B0, 1, 0); SCHED; LDA(At, 1, 0); STAGE(SA(0, 1), A, brow + HALF, t + 2);
            WAIT_L(8); BAR; WAIT_L(0); MMA(0, 0, At, B0); BAR; SCHED;
            LDB(B1, 1, 1); STAGE(SB(1, 0), Bt, bcol, t + 3);
            BAR; WAIT_L(0); MMA(0, 1, At, B1); BAR;
            LDA(At, 1, 1); STAGE(SA(1, 0), A, brow, t + 3);
            BAR; WAIT_L(0); MMA(1, 0, At, B0); BAR; SCHED;
            STAGE(SB(1, 1), Bt, bcol + HALF, t + 3);
            WAIT_V(6); BAR; MMA(1, 1, At, B1); BAR;
        }
        { LDB(B0, 0, 0); LDA(At, 0, 0); STAGE(SA(1, 1), A, brow + HALF, nt - 1);
          BAR; WAIT_L(0); MMA(0, 0, At, B0); BAR;
          LDB(B1, 0, 1); BAR; WAIT_L(0); MMA(0, 1, At, B1); BAR;
          LDA(At, 0, 1); WAIT_V(4); BAR; WAIT_L(0); MMA(1, 0, At, B0); MMA(1, 1, At, B1); BAR; }
        { LDB(B0, 1, 0); LDA(At, 1, 0); WAIT_V(2); BAR; WAIT_L(0); MMA(0, 0, At, B0); BAR;
          LDB(B1, 1, 1); WAIT_V(0); BAR; WAIT_L(0); MMA(0, 1, At, B1); BAR;
          LDA(At, 1, 1); BAR; WAIT_L(0); MMA(1, 0, At, B0); MMA(1, 1, At, B1); BAR; }
        if (wr == 0) BAR;
        const int cbrow = brow, cpn = pn;
        L += G;
        const bool more = L < nwg;
        if (more) {
            TILE_COORDS();
            STAGE(SB(0, 0), Bt, bcol, 0); STAGE(SA(0, 0), A, brow, 0);
            STAGE(SB(0, 1), Bt, bcol + HALF, 0); STAGE(SA(0, 1), A, brow + HALF, 0);
        }
        epi(acc, cbrow, cpn, wr, wc, fr, fq);
        if (!more) break;
    }
    WAIT_V(0);
#undef TILE_COORDS
}
#undef SA
#undef SB
#undef STAGE
#undef LDA
#undef LDB
#undef MMA
}

template <bool FINAL>
__device__ __forceinline__ void phase_ln(float* y, bf16_t* xb, const float* g, const float* bta, int wv) {
    const int tidl = tidx(wv);
    const int wid = tidl >> 6, lane = tidl & 63;
    const int gw = bidx() * 8 + wid, NW = gdim() * 8;
    f32x4 gv[4], bv[4];
#pragma unroll
    for (int j = 0; j < 4; ++j) { gv[j] = *(const f32x4*)(g + j * 256 + lane * 4); bv[j] = *(const f32x4*)(bta + j * 256 + lane * 4); }
    for (int row = gw; row < TOK; row += NW) {
        float* yr = y + (size_t)row * DM;
        f32x4 v[4]; float s = 0.f;
#pragma unroll
        for (int j = 0; j < 4; ++j) { v[j] = *(const f32x4*)(yr + j * 256 + lane * 4); s += (v[j][0] + v[j][1]) + (v[j][2] + v[j][3]); }
        const float mean = wave_sum(s, lane) * (1.f / DM); float s2 = 0.f;
#pragma unroll
        for (int j = 0; j < 4; ++j) { v[j] = v[j] - mean; s2 += (v[j][0] * v[j][0] + v[j][1] * v[j][1]) + (v[j][2] * v[j][2] + v[j][3] * v[j][3]); }
        const float rstd = rsqrtf(wave_sum(s2, lane) * (1.f / DM) + LN_EPS);
#pragma unroll
        for (int j = 0; j < 4; ++j) {
            const f32x4 o = v[j] * rstd * gv[j] + bv[j];
            if (FINAL) *(f32x4*)(yr + j * 256 + lane * 4) = o;
            else { u32x2 w; w.x = cvt_pk_bf16(o[0], o[1]); w.y = cvt_pk_bf16(o[2], o[3]); *(u32x2*)(xb + (size_t)row * DM + j * 256 + lane * 4) = w; }
        }
    }
}

__device__ __forceinline__ void gmlp_unit(const Params& p, int l, int chunk, int wv) {
    const bf16_t* proj = (const bf16_t*)(wsp(p) + WS_HP);
    bf16_t* mix = (bf16_t*)(wsp(p) + WS_MIX);
    bf16_t* vT = (bf16_t*)dyn_lds;
    const int tid = tidx(wv), wid = tid >> 6, lane = tid & 63, fr = lane & 15, fq = lane >> 4;
    const size_t tok0 = (size_t)chunk * 128;
    {
        const f32x4 gg = *(const f32x4*)(pin(p, 8) + l * 256 + lane * 4), bb = *(const f32x4*)(pin(p, 9) + l * 256 + lane * 4);
#pragma unroll 4
        for (int i = 0; i < 16; ++i) {
            const int q = wid * 16 + i;
            const u32x2 w = *(const u32x2*)(proj + (tok0 + q) * NPROJ + C_V + lane * 4);
            float z0 = gelu_tanh(bflo(w.x)), z1 = gelu_tanh(bfhi(w.x)), z2 = gelu_tanh(bflo(w.y)), z3 = gelu_tanh(bfhi(w.y));
            const float mean = wave_sum((z0 + z1) + (z2 + z3), lane) * (1.f / 256.f);
            z0 -= mean; z1 -= mean; z2 -= mean; z3 -= mean;
            const float rstd = rsqrtf(wave_sum((z0 * z0 + z1 * z1) + (z2 * z2 + z3 * z3), lane) * (1.f / 256.f) + LN_EPS);
            vT[(lane * 4 + 0) * 136 + q] = f2bf(z0 * rstd * gg[0] + bb[0]);
            vT[(lane * 4 + 1) * 136 + q] = f2bf(z1 * rstd * gg[1] + bb[1]);
            vT[(lane * 4 + 2) * 136 + q] = f2bf(z2 * rstd * gg[2] + bb[2]);
            vT[(lane * 4 + 3) * 136 + q] = f2bf(z3 * rstd * gg[3] + bb[3]);
        }
    }
    __syncthreads();
    const int h = wid >> 1, pbase = (wid & 1) * 64;
    const bf16_t* W = (const bf16_t*)(wsp(p) + WS_GM) + ((size_t)(l * 4 + h) * 128) * 128;
    f32x4 acc[4][4] = {};
#pragma unroll
    for (int ks = 0; ks < 4; ++ks) {
        bf16x8 wf[4], vf[4];
#pragma unroll
        for (int pt = 0; pt < 4; ++pt) wf[pt] = *(const bf16x8*)(W + (size_t)(pbase + pt * 16 + fr) * 128 + ks * 32 + fq * 8);
#pragma unroll
        for (int dt = 0; dt < 4; ++dt) vf[dt] = *(const bf16x8*)(vT + (h * 64 + dt * 16 + fr) * 136 + ks * 32 + fq * 8);
#pragma unroll
        for (int pt = 0; pt < 4; ++pt)
#pragma unroll
            for (int dt = 0; dt < 4; ++dt) acc[pt][dt] = __builtin_amdgcn_mfma_f32_16x16x32_bf16(vf[dt], wf[pt], acc[pt][dt], 0, 0, 0);
    }
#pragma unroll
    for (int pt = 0; pt < 4; ++pt) {
        const int pp = pbase + pt * 16 + fr;
        const float bs = pin(p, 11)[(l * 4 + h) * 128 + pp];
#pragma unroll
        for (int dt = 0; dt < 4; ++dt) {
            const int col = h * 64 + dt * 16 + fq * 4;
            const u32x2 uw = *(const u32x2*)(proj + (tok0 + pp) * NPROJ + C_U + col);
            const f32x4 a = acc[pt][dt];
            u32x2 w; w.x = cvt_pk_bf16(gelu_tanh(bflo(uw.x)) * (a[0] + bs), gelu_tanh(bfhi(uw.x)) * (a[1] + bs));
            w.y = cvt_pk_bf16(gelu_tanh(bflo(uw.y)) * (a[2] + bs), gelu_tanh(bfhi(uw.y)) * (a[3] + bs));
            *(u32x2*)(mix + (tok0 + pp) * DM + 256 + col) = w;
        }
    }
    __syncthreads();
}

__device__ __forceinline__ void compress_unit(const Params& p, int l, int unit, int wv) {
    const int nt = unit & 15, bg = (unit >> 4) & 15, kv = unit >> 8, b = bg >> 1, g = bg & 1;
    const bf16_t* proj = (const bf16_t*)(wsp(p) + WS_HP);
    const bf16_t* W1 = (const bf16_t*)(wsp(p) + WS_C1) + (size_t)(l * 2 + kv) * 128 * 2048;
    const bf16_t* W2 = (const bf16_t*)(wsp(p) + WS_C2) + (size_t)(l * 2 + kv) * 64 * 128;
    const float* b1f = (const float*)(wsp(p) + WS_B1) + (l * 2 + kv) * 128;
    bf16_t* outp = (bf16_t*)(wsp(p) + WS_KCMP) + ((size_t)(kv * 16 + bg) * 256) * 64;
    bf16_t* hS = (bf16_t*)dyn_lds;
    const int tid = tidx(wv), wid = tid >> 6, lane = tid & 63, fr = lane & 15, fq = lane >> 4;
    int n = nt * 16 + fr; if (n > 254) n = 254;
    const bf16_t* arow = proj + ((size_t)b * SEQ + 16 * n) * NPROJ + (kv ? C_VC : C_KC) + g * 64 + fq * 8;
    const bf16_t* brow = W1 + (size_t)(wid * 16 + fr) * 2048 + fq * 8;
    f32x4 acc = {0.f, 0.f, 0.f, 0.f};
#pragma unroll 16
    for (int kk = 0; kk < 64; ++kk) {
        const bf16x8 a = *(const bf16x8*)(arow + (size_t)(kk >> 1) * NPROJ + (kk & 1) * 32);
        const bf16x8 w = *(const bf16x8*)(brow + kk * 32);
        acc = __builtin_amdgcn_mfma_f32_16x16x32_bf16(a, w, acc, 0, 0, 0);
    }
    {
        const float bias = b1f[wid * 16 + fr];
#pragma unroll
        for (int j = 0; j < 4; ++j) hS[(fq * 4 + j) * 136 + wid * 16 + fr] = f2bf(gelu_tanh(acc[j] + bias));
    }
    __syncthreads();
    if (wid < 4) {
        f32x4 o = {0.f, 0.f, 0.f, 0.f};
#pragma unroll
        for (int ks = 0; ks < 4; ++ks) {
            const bf16x8 hf = *(const bf16x8*)(hS + fr * 136 + ks * 32 + fq * 8);
            const bf16x8 wf = *(const bf16x8*)(W2 + (size_t)(wid * 16 + fr) * 128 + ks * 32 + fq * 8);
            o = __builtin_amdgcn_mfma_f32_16x16x32_bf16(wf, hf, o, 0, 0, 0);
        }
        const int nn = nt * 16 + fr;
        u32x2 w; w.x = cvt_pk_bf16(o[0], o[1]); w.y = cvt_pk_bf16(o[2], o[3]);
        if (nn > 254) { w.x = 0; w.y = 0; }
        if (kv == 0) *(u32x2*)(outp + (size_t)nn * 64 + wid * 16 + fq * 4) = w;
        else {
            const unsigned short e0 = (unsigned short)(w.x & 0xffff), e1 = (unsigned short)(w.x >> 16), e2 = (unsigned short)(w.y & 0xffff), e3 = (unsigned short)(w.y >> 16);
            bf16_t* op = outp + (size_t)(wid * 16 + fq * 4) * 256 + nn;
            op[0] = e0; op[256] = e1; op[512] = e2; op[768] = e3;
        }
    }
    __syncthreads();
}

__device__ __forceinline__ u32x4 vtrans_load(const Params& p, int job, int tid) {
    const int tile = job & 63, bg = (job >> 6) & 15, which = job >> 10, b = bg >> 1, g = bg & 1;
    const bf16_t* src = (const bf16_t*)(wsp(p) + WS_HP) + ((size_t)b * SEQ + tile * 64) * NPROJ + (which ? C_VW : C_VS) + g * 64;
    return *(const u32x4*)(src + (size_t)(tid >> 3) * NPROJ + (tid & 7) * 8);
}
__device__ __forceinline__ void vtrans_store(const Params& p, int job, int tid, const u32x4 v) {
    const int tile = job & 63, bg = (job >> 6) & 15, which = job >> 10;
    bf16_t* dst = (bf16_t*)(wsp(p) + WS_VT) + ((size_t)(which * 16 + bg) * 64) * SEQ + tile * 64;
    bf16_t* s = (bf16_t*)dyn_lds;
    {
        const int tok = tid >> 3, c = tid & 7;
        s[(c * 8 + 0) * 72 + tok] = (bf16_t)(v.x & 0xffff); s[(c * 8 + 1) * 72 + tok] = (bf16_t)(v.x >> 16);
        s[(c * 8 + 2) * 72 + tok] = (bf16_t)(v.y & 0xffff); s[(c * 8 + 3) * 72 + tok] = (bf16_t)(v.y >> 16);
        s[(c * 8 + 4) * 72 + tok] = (bf16_t)(v.z & 0xffff); s[(c * 8 + 5) * 72 + tok] = (bf16_t)(v.z >> 16);
        s[(c * 8 + 6) * 72 + tok] = (bf16_t)(v.w & 0xffff); s[(c * 8 + 7) * 72 + tok] = (bf16_t)(v.w >> 16);
    }
    __syncthreads();
    {
        const int d = tid >> 3, c = tid & 7;
        *(u32x4*)(dst + (size_t)d * SEQ + c * 8) = *(const u32x4*)(s + d * 72 + c * 8);
    }
    __syncthreads();
}
__device__ __forceinline__ void vtrans_all(const Params& p, int wv) {
    const int tid = tidx(wv), G = gdim();
    int u = bidx();
    u32x4 cur = {0u, 0u, 0u, 0u}, nxt = cur;
    if (u < 2048) cur = vtrans_load(p, u, tid);
    while (u < 2048) {
        const int un = u + G;
        if (un < 2048) nxt = vtrans_load(p, un, tid);
        vtrans_store(p, u, tid, cur);
        cur = nxt; u = un;
    }
}

__device__ __forceinline__ void conv_items(const Params& p, int l, int wv) {
    const bf16_t* proj = (const bf16_t*)(wsp(p) + WS_HP);
    bf16_t* mix = (bf16_t*)(wsp(p) + WS_MIX);
    const float* cw = pin(p, 7) + (size_t)l * 3 * 256;
    const int total = TOK * 32;
    for (int idx = bidx() * 512 + tidx(wv); idx < total; idx += gdim() * 512) {
        const int t = idx >> 5, c8 = (idx & 31) * 8, s = t & (SEQ - 1);
        const bf16_t* row = proj + (size_t)t * NPROJ;
        float accv[8] = {0.f, 0.f, 0.f, 0.f, 0.f, 0.f, 0.f, 0.f};
#pragma unroll
        for (int w = 0; w < 3; ++w) {
            if (s - 2 + w >= 0) {
                const bf16_t* r2 = row - (size_t)(2 - w) * NPROJ;
                const u32x4 hh = *(const u32x4*)(r2 + C_HA + c8), cc = *(const u32x4*)(r2 + C_CA + c8);
                const f32x4 k0 = *(const f32x4*)(cw + w * 256 + c8), k1 = *(const f32x4*)(cw + w * 256 + c8 + 4);
                accv[0] += k0[0] * bflo(hh.x) * bflo(cc.x); accv[1] += k0[1] * bfhi(hh.x) * bfhi(cc.x);
                accv[2] += k0[2] * bflo(hh.y) * bflo(cc.y); accv[3] += k0[3] * bfhi(hh.y) * bfhi(cc.y);
                accv[4] += k1[0] * bflo(hh.z) * bflo(cc.z); accv[5] += k1[1] * bfhi(hh.z) * bfhi(cc.z);
                accv[6] += k1[2] * bflo(hh.w) * bflo(cc.w); accv[7] += k1[3] * bfhi(hh.w) * bfhi(cc.w);
            }
        }
        const u32x4 bb = *(const u32x4*)(row + C_BA + c8);
        u32x4 o;
        o.x = cvt_pk_bf16(accv[0] * bflo(bb.x), accv[1] * bfhi(bb.x)); o.y = cvt_pk_bf16(accv[2] * bflo(bb.y), accv[3] * bfhi(bb.y));
        o.z = cvt_pk_bf16(accv[4] * bflo(bb.z), accv[5] * bfhi(bb.z)); o.w = cvt_pk_bf16(accv[6] * bflo(bb.w), accv[7] * bfhi(bb.w));
        *(u32x4*)(mix + (size_t)t * DM + c8) = o;
    }
}

__device__ __forceinline__ void phase_mixA(const Params& p, int l, int wv) {
    const int G = gdim();
    for (int u = bidx(); u < 256; u += G) gmlp_unit(p, l, u, wv);
    for (int u = bidx(); u < 512; u += G) compress_unit(p, l, u, wv);
    vtrans_all(p, wv);
    conv_items(p, l, wv);
}

namespace at {
constexpr float SC = 0.125f * 1.44269504089f;
constexpr float NEGBIG = -1e30f;
constexpr int RD = 4;
constexpr int SLOT = 16384;
constexpr int OFF_IMP = RD * SLOT;
constexpr int OFF_SELM = OFF_IMP + 65536;

struct Stream {
    const bf16_t *kcmp, *vcmpT, *ksel, *vselT, *kwin, *vwinT;
    int n0, nsel, w0, ntot;
};
__device__ __forceinline__ void issue_tile(const Stream& S, int tau, int tid) {
    const bf16_t *kb, *vb; int ldk, ldv;
    if (tau < 2 * S.n0) { const int t = tau < S.n0 ? tau : tau - S.n0; kb = S.kcmp + t * 64 * 64; ldk = 64; vb = S.vcmpT + t * 64; ldv = 256; }
    else if (tau < 2 * S.n0 + S.nsel) { const int t = tau - 2 * S.n0; kb = S.ksel + (size_t)t * 64 * NPROJ; ldk = NPROJ; vb = S.vselT + t * 64; ldv = SEQ; }
    else { const int t = S.w0 + tau - (2 * S.n0 + S.nsel); kb = S.kwin + (size_t)t * 64 * NPROJ; ldk = NPROJ; vb = S.vwinT + t * 64; ldv = SEQ; }
    const int row = tid >> 3, chk = (tid & 7) ^ (((row >> 1) & 1) | (((row >> 3) & 3) << 1)), chv = (tid & 7) ^ ((row >> 1) & 7);
    unsigned char* slot = dyn_lds + (tau & (RD - 1)) * SLOT;
    __builtin_amdgcn_global_load_lds((const unsigned*)(kb + (size_t)row * ldk + chk * 8), (unsigned*)(slot + tid * 16), 16, 0, 0);
    __builtin_amdgcn_global_load_lds((const unsigned*)(vb + (size_t)row * ldv + chv * 8), (unsigned*)(slot + 8192 + tid * 16), 16, 0, 0);
}

template <int MODE, bool MASKED>
__device__ __forceinline__ void tile_compute(const unsigned char* Ks, const unsigned char* Vt, const bf16x8 (&qf)[2][2], f32x4 (&o)[2][4], float (&m)[2], float (&lsum)[2],
                                             const float (&invl)[2], const int (&lo)[2], const int (&hi)[2], const bool (&act)[2], f32x4 (&s)[2][4], int fr, int fq) {
#pragma unroll
    for (int kt = 0; kt < 4; ++kt) {
        const int krow = (kt >> 1) * 32 + (fr >> 2) * 8 + (kt & 1) * 4 + (fr & 3);
        const int ksw = ((krow >> 1) & 1) | (((krow >> 3) & 3) << 1);
        const bf16x8 k0 = *(const bf16x8*)(Ks + krow * 128 + ((fq ^ ksw) << 4)), k1 = *(const bf16x8*)(Ks + krow * 128 + (((4 + fq) ^ ksw) << 4));
#pragma unroll
        for (int grp = 0; grp < 2; ++grp) {
            f32x4 z = {0.f, 0.f, 0.f, 0.f};
            z = __builtin_amdgcn_mfma_f32_16x16x32_bf16(k0, qf[grp][0], z, 0, 0, 0);
            s[grp][kt] = __builtin_amdgcn_mfma_f32_16x16x32_bf16(k1, qf[grp][1], z, 0, 0, 0);
        }
    }
    bf16x8 pf[2][2];
#pragma unroll
    for (int grp = 0; grp < 2; ++grp) {
        float mx = m[grp];
        if (MASKED) {
#pragma unroll
            for (int kt = 0; kt < 4; ++kt)
#pragma unroll
                for (int jj = 0; jj < 4; ++jj) {
                    const int kl = (kt >> 1) * 32 + fq * 8 + (kt & 1) * 4 + jj;
                    const float v = (kl >= lo[grp] && kl <= hi[grp]) ? s[grp][kt][jj] : NEGBIG;
                    s[grp][kt][jj] = v; mx = fmaxf(mx, v);
                }
        } else {
            float t0 = fmaxf(fmaxf(s[grp][0][0], s[grp][0][1]), fmaxf(s[grp][0][2], s[grp][0][3]));
#pragma unroll
            for (int kt = 1; kt < 4; ++kt) t0 = fmaxf(fmaxf(t0, s[grp][kt][0]), fmaxf(fmaxf(s[grp][kt][1], s[grp][kt][2]), s[grp][kt][3]));
            mx = fmaxf(mx, t0);
        }
        float alpha = 1.f;
        if (MODE != 1) {
            mx = fmaxf(mx, shx(mx, 16, fq * 16 + fr)); mx = fmaxf(mx, shx(mx, 32, fq * 16 + fr));
            if (!MASKED) mx = act[grp] ? mx : m[grp];
            alpha = fexp2((m[grp] - mx) * SC); m[grp] = mx;
        } else mx = m[grp];
        const float msc = mx * SC;
        float rs = 0.f;
#pragma unroll
        for (int kt = 0; kt < 4; ++kt)
#pragma unroll
            for (int jj = 0; jj < 4; ++jj) {
                const float v = s[grp][kt][jj];
                float pv = fexp2(__builtin_fmaf(v, SC, -msc));
                if (MASKED) pv = (v > -1e29f) ? pv : 0.f;
                if (MODE == 1) pv *= invl[grp];
                rs += pv; s[grp][kt][jj] = pv;
            }
        if (!MASKED) rs = act[grp] ? rs : 0.f;
        if (MODE != 1) lsum[grp] = lsum[grp] * alpha + rs;
        if (MODE == 2) {
            if (__any(alpha != 1.f)) {
#pragma unroll
                for (int dt = 0; dt < 4; ++dt) o[grp][dt] = o[grp][dt] * alpha;
            }
        }
        if (MODE != 0) {
#pragma unroll
            for (int kk = 0; kk < 2; ++kk) {
                u32x4 w;
                w.x = cvt_pk_bf16(s[grp][2 * kk][0], s[grp][2 * kk][1]); w.y = cvt_pk_bf16(s[grp][2 * kk][2], s[grp][2 * kk][3]);
                w.z = cvt_pk_bf16(s[grp][2 * kk + 1][0], s[grp][2 * kk + 1][1]); w.w = cvt_pk_bf16(s[grp][2 * kk + 1][2], s[grp][2 * kk + 1][3]);
                if (!MASKED) { w.x = act[grp] ? w.x : 0u; w.y = act[grp] ? w.y : 0u; w.z = act[grp] ? w.z : 0u; w.w = act[grp] ? w.w : 0u; }
                pf[grp][kk] = __builtin_bit_cast(bf16x8, w);
            }
        }
    }
    if (MODE != 0) {
#pragma unroll
        for (int kk = 0; kk < 2; ++kk) {
#pragma unroll
            for (int dt = 0; dt < 4; ++dt) {
                const int drow = dt * 16 + fr;
                const bf16x8 vf = *(const bf16x8*)(Vt + drow * 128 + (((kk * 4 + fq) ^ ((drow >> 1) & 7)) << 4));
#pragma unroll
                for (int grp = 0; grp < 2; ++grp) o[grp][dt] = __builtin_amdgcn_mfma_f32_16x16x32_bf16(vf, pf[grp][kk], o[grp][dt], 0, 0, 0);
            }
        }
    }
}

template <int BR>
__device__ __forceinline__ void branch(const Stream& S, int& tau, int t0, int t1, int qt, const bf16x8 (&qf)[2][2], f32x4 (&o)[2][4], float (&m)[2], float (&lsum)[2],
                                       const float (&invl)[2], const int (&ql)[2], const int (&nmax)[2], const unsigned (&mlo)[2], const unsigned (&mhi)[2],
                                       float* impA, float* impB, int fr, int fq, int tid) {
#pragma unroll 1
    for (int t = t0; t < t1; ++t, ++tau) {
        if (tau + RD - 2 < S.ntot) asm volatile("s_waitcnt vmcnt(4)" ::: "memory"); else asm volatile("s_waitcnt vmcnt(0)" ::: "memory");
        __builtin_amdgcn_s_barrier();
        asm volatile("" ::: "memory");
        if (tau + RD - 1 < S.ntot) issue_tile(S, tau + RD - 1, tid);
        const unsigned char* Ks = dyn_lds + (tau & (RD - 1)) * SLOT;
        int lo[2], hi[2]; bool act[2];
        bool boundary;
        if (BR <= 1) boundary = true; else if (BR == 2) boundary = (t == qt); else boundary = (t == qt) || (t == qt - 8);
#pragma unroll
        for (int grp = 0; grp < 2; ++grp) {
            if (BR <= 1) { lo[grp] = 0; hi[grp] = nmax[grp] - 64 * t; act[grp] = true; }
            else if (BR == 2) { const unsigned bit = (t < 32) ? (mlo[grp] >> t) : (mhi[grp] >> (t - 32)); act[grp] = (bit & 1u) != 0; lo[grp] = 0; hi[grp] = act[grp] ? ql[grp] : -1; }
            else { act[grp] = true; lo[grp] = (t == qt - 8) ? ql[grp] + 1 : 0; hi[grp] = (t == qt) ? ql[grp] : 63; }
        }
        f32x4 s[2][4];
        constexpr int MD = (BR == 0) ? 0 : (BR == 1 ? 1 : 2);
        if (BR <= 1 || boundary) tile_compute<MD, true>(Ks, Ks + 8192, qf, o, m, lsum, invl, lo, hi, act, s, fr, fq);
        else tile_compute<MD, false>(Ks, Ks + 8192, qf, o, m, lsum, invl, lo, hi, act, s, fr, fq);
        if (BR == 1) {
#pragma unroll
            for (int grp = 0; grp < 2; ++grp)
#pragma unroll
                for (int kt = 0; kt < 4; ++kt) {
                    float a = (s[grp][kt][0] + s[grp][kt][1]) + (s[grp][kt][2] + 0.5f * s[grp][kt][3]), b2 = 0.5f * s[grp][kt][3];
                    a += shx(a, 1, fq * 16 + fr); a += shx(a, 2, fq * 16 + fr);
                    b2 += shx(b2, 1, fq * 16 + fr); b2 += shx(b2, 2, fq * 16 + fr);
                    if ((fr & 3) == 0) {
                        const int J = 16 * t + (kt >> 1) * 8 + fq * 2 + (kt & 1);
                        impA[ql[grp] * 64 + J] = a;
                        if (J + 1 < 64) impB[ql[grp] * 64 + J + 1] = b2;
                    }
                }
        }
    }
}

__device__ __forceinline__ void attn_unit(const Params& p, int l, int bg, int qt, int wv) {
    const int b = bg >> 1, g = bg & 1;
    const int tid = tidx(wv), wid = tid >> 6, lane = tid & 63, fr = lane & 15, fq = lane >> 4;
    float* impA = (float*)(dyn_lds + OFF_IMP);
    float* impB = impA + 4096;
    unsigned* selm = (unsigned*)(dyn_lds + OFF_SELM);
    f32x4* outa = (f32x4*)(dyn_lds + OFF_IMP) + tid;
    const bf16_t* proj = (const bf16_t*)(wsp(p) + WS_HP);
    bf16_t* mix = (bf16_t*)(wsp(p) + WS_MIX);
    const size_t tokb = (size_t)b * SEQ;
    Stream S;
    S.kcmp = (const bf16_t*)(wsp(p) + WS_KCMP) + ((size_t)(0 * 16 + bg) * 256) * 64;
    S.vcmpT = (const bf16_t*)(wsp(p) + WS_KCMP) + ((size_t)(1 * 16 + bg) * 256) * 64;
    S.ksel = proj + tokb * NPROJ + C_KS + g * 64; S.kwin = proj + tokb * NPROJ + C_KW + g * 64;
    S.vselT = (const bf16_t*)(wsp(p) + WS_VT) + ((size_t)(0 * 16 + bg) * 64) * SEQ;
    S.vwinT = (const bf16_t*)(wsp(p) + WS_VT) + ((size_t)(1 * 16 + bg) * 64) * SEQ;
    S.n0 = (qt >> 4) + 1; S.nsel = qt + 1; S.w0 = (qt >= 8) ? qt - 8 : 0; S.ntot = 2 * S.n0 + S.nsel + (qt - S.w0 + 1);
    __syncthreads();
#pragma unroll
    for (int i = 0; i < RD - 1; ++i) if (i < S.ntot) issue_tile(S, i, tid);
    const int r = fr & 3, head = g * 4 + r;
    int ql[2], nmax[2]; size_t qtok[2];
    bf16x8 qf[2][2];
    float gate[2][3];
#pragma unroll
    for (int grp = 0; grp < 2; ++grp) {
        ql[grp] = wid * 8 + grp * 4 + (fr >> 2);
        qtok[grp] = tokb + qt * 64 + ql[grp];
        nmax[grp] = (qt * 64 + ql[grp] - 31) >> 4;
        const bf16_t* qp = proj + qtok[grp] * NPROJ;
        qf[grp][0] = *(const bf16x8*)(qp + C_Q + head * 64 + fq * 8);
        qf[grp][1] = *(const bf16x8*)(qp + C_Q + head * 64 + 32 + fq * 8);
#pragma unroll
        for (int br = 0; br < 3; ++br) gate[grp][br] = sigmoidf_(bf2f(qp[C_GL + head * 3 + br]));
    }
    f32x4 o[2][4];
    float m[2], lsum[2], invl[2] = {0.f, 0.f};
    unsigned mlo[2] = {0u, 0u}, mhi[2] = {0u, 0u};
    int tau = 0;
#pragma unroll
    for (int grp = 0; grp < 2; ++grp) { m[grp] = NEGBIG; lsum[grp] = 0.f; }
    branch<0>(S, tau, 0, S.n0, qt, qf, o, m, lsum, invl, ql, nmax, mlo, mhi, impA, impB, fr, fq, tid);
#pragma unroll
    for (int grp = 0; grp < 2; ++grp) {
        float ls = lsum[grp]; ls += shx(ls, 16, fq * 16 + fr); ls += shx(ls, 32, fq * 16 + fr);
        invl[grp] = ls > 0.f ? fast_rcp(ls) : 0.f;
#pragma unroll
        for (int dt = 0; dt < 4; ++dt) o[grp][dt] = (f32x4){0.f, 0.f, 0.f, 0.f};
    }
    branch<1>(S, tau, 0, S.n0, qt, qf, o, m, lsum, invl, ql, nmax, mlo, mhi, impA, impB, fr, fq, tid);
    __syncthreads();
#pragma unroll 1
    for (int qi = 0; qi < 8; ++qi) {
        const int q = wid * 8 + qi, J = lane;
        const float v = impA[q * 64 + J] + (J > 0 ? impB[q * 64 + J] : 0.f);
        const bool valid = J <= qt, forced = (J == 0) || (J == qt) || (J == qt - 1);
        const float sc = forced ? 3e38f : (valid ? v : -3e38f);
        int rank = 0;
#pragma unroll
        for (int jj = 0; jj < 64; ++jj) {
            const float ov = __int_as_float(__builtin_amdgcn_readlane(__float_as_int(sc), jj));
            rank += ((ov > sc) || (ov == sc && jj < J)) ? 1 : 0;
        }
        const unsigned long long mk = __ballot((rank < 16) && valid);
        if (lane == 0) { selm[q * 2] = (unsigned)mk; selm[q * 2 + 1] = (unsigned)(mk >> 32); }
    }
    __syncthreads();
#pragma unroll
    for (int grp = 0; grp < 2; ++grp) {
        mlo[grp] = selm[ql[grp] * 2]; mhi[grp] = selm[ql[grp] * 2 + 1];
#pragma unroll
        for (int dt = 0; dt < 4; ++dt) outa[(grp * 4 + dt) * 512] = o[grp][dt] * gate[grp][0];
    }
#pragma unroll
    for (int grp = 0; grp < 2; ++grp) { m[grp] = NEGBIG; lsum[grp] = 0.f;
#pragma unroll
        for (int dt = 0; dt < 4; ++dt) o[grp][dt] = (f32x4){0.f, 0.f, 0.f, 0.f}; }
    branch<2>(S, tau, 0, qt + 1, qt, qf, o, m, lsum, invl, ql, nmax, mlo, mhi, impA, impB, fr, fq, tid);
#pragma unroll
    for (int grp = 0; grp < 2; ++grp) {
        float ls = lsum[grp]; ls += shx(ls, 16, fq * 16 + fr); ls += shx(ls, 32, fq * 16 + fr);
        const float sc2 = (ls > 0.f ? fast_rcp(ls) : 0.f) * gate[grp][1];
#pragma unroll
        for (int dt = 0; dt < 4; ++dt) { outa[(grp * 4 + dt) * 512] = outa[(grp * 4 + dt) * 512] + o[grp][dt] * sc2; o[grp][dt] = (f32x4){0.f, 0.f, 0.f, 0.f}; }
        m[grp] = NEGBIG; lsum[grp] = 0.f;
    }
    branch<3>(S, tau, S.w0, qt + 1, qt, qf, o, m, lsum, invl, ql, nmax, mlo, mhi, impA, impB, fr, fq, tid);
#pragma unroll
    for (int grp = 0; grp < 2; ++grp) {
        float ls = lsum[grp]; ls += shx(ls, 16, fq * 16 + fr); ls += shx(ls, 32, fq * 16 + fr);
        const float sc2 = (ls > 0.f ? fast_rcp(ls) : 0.f) * gate[grp][2];
#pragma unroll
        for (int dt = 0; dt < 4; ++dt) {
            const f32x4 v = outa[(grp * 4 + dt) * 512] + o[grp][dt] * sc2;
            u32x2 w; w.x = cvt_pk_bf16(v[0], v[1]); w.y = cvt_pk_bf16(v[2], v[3]);
            *(u32x2*)(mix + qtok[grp] * DM + 512 + head * 64 + dt * 16 + fq * 4) = w;
        }
    }
}

__device__ __forceinline__ void phase_attn(const Params& p, int l, int wv) {
    for (int u = bidx(); u < 1024; u += gdim()) {
        const int rnd = u >> 8, w = u & 255, bg = w >> 4, i = w & 15;
        const int qt = (rnd == 0) ? 63 - i : (rnd == 1) ? 32 + i : (rnd == 2) ? 31 - i : i;
        attn_unit(p, l, bg, qt, wv);
    }
    asm volatile("s_waitcnt vmcnt(0)" ::: "memory");
    __syncthreads();
}
}

#define XB_TMO      128
#define XB_XCNT(j)  (256  + 64 * (j))
#define XB_XSUB(j)  (1280 + 64 * (j))
#define XB_XGEN(j)  (2304 + 64 * (j))
#define XB_TOP      3328
#define XB_TOPGEN   3392
#define XCD_BAR_WORDS 3456
#define XB_SPIN_CAP (1u << 20)
#define LAS __attribute__((address_space(3)))
__device__ __forceinline__ unsigned xb_ld(unsigned* p)              { return __hip_atomic_load(p, __ATOMIC_RELAXED, __HIP_MEMORY_SCOPE_AGENT); }
__device__ __forceinline__ unsigned xb_add(unsigned* p, unsigned v) { return __hip_atomic_fetch_add(p, v, __ATOMIC_RELAXED, __HIP_MEMORY_SCOPE_AGENT); }
__device__ __forceinline__ unsigned xb_xcc_id() { return (unsigned)__builtin_amdgcn_s_getreg((3 << 11) | 20) & 0xFu; }
#define XB_SPIN(cond, bar) do { unsigned _sp = 0; while (cond) { __builtin_amdgcn_s_sleep(1); \
    if ((++_sp & 255u) == 0u) { if (xb_ld(&(bar)[XB_TMO])) break; if (_sp > XB_SPIN_CAP) { atomicAdd(&(bar)[XB_TMO], 1u); break; } } } } while (0)
struct XcdBarrier { unsigned* bar; unsigned x; volatile LAS unsigned* st; };
__device__ __forceinline__ XcdBarrier xcd_barrier_post(unsigned* bar, volatile LAS unsigned* st, int wv) {
    XcdBarrier b; b.bar = bar; b.x = xb_xcc_id(); b.st = st;
    if (tidx(wv) == 0) (void)xb_add(&bar[XB_XCNT(b.x)], 1u);
    return b;
}
__device__ __forceinline__ void xcd_barrier_complete(unsigned* bar, unsigned x, unsigned& nloc, unsigned& nx) {
    const unsigned G = gdim();
    unsigned sum, cnt, mine, sp = 0u;
    for (;;) {
        sum = 0u; cnt = 0u; mine = 0u;
#pragma unroll
        for (unsigned j = 0; j < 16; ++j) { const unsigned c = xb_ld(&bar[XB_XCNT(j)]); sum += c; cnt += (c > 0u) ? 1u : 0u; mine = (j == x) ? c : mine; }
        if (sum == G) break;
        __builtin_amdgcn_s_sleep(1);
        if ((++sp & 255u) == 0u) { if (xb_ld(&bar[XB_TMO])) break; if (sp > XB_SPIN_CAP) { atomicAdd(&bar[XB_TMO], 1u); break; } }
    }
    nloc = mine > 0u ? mine : 1u; nx = cnt > 0u ? cnt : 1u;
}
__device__ __forceinline__ void xcd_barrier(const XcdBarrier& b, int wv) {
    asm volatile("s_waitcnt vmcnt(0)" ::: "memory");
    __syncthreads();
    if (tidx(wv) == 0) {
        unsigned* bar = b.bar; asm volatile("" : "+s"(bar));
        __builtin_amdgcn_s_waitcnt(0);
        unsigned nloc = b.st[0], nx = b.st[1];
        if (nloc == 0u) { xcd_barrier_complete(bar, b.x, nloc, nx); b.st[0] = nloc; b.st[1] = nx; }
        const unsigned old = xb_add(&bar[XB_XSUB(b.x)], 1u);
        const unsigned gen = old / nloc;
        if (old + 1u == (gen + 1u) * nloc) {
            __builtin_amdgcn_fence(__ATOMIC_RELEASE, "agent");
            asm volatile("s_waitcnt vmcnt(0)" ::: "memory");
            const unsigned og = xb_add(&bar[XB_TOP], 1u);
            const unsigned tg = og / nx;
            if (og + 1u == (tg + 1u) * nx) xb_add(&bar[XB_TOPGEN], 1u);
            else XB_SPIN(xb_ld(&bar[XB_TOPGEN]) == tg, bar);
            __builtin_amdgcn_fence(__ATOMIC_ACQUIRE, "agent");
            xb_add(&bar[XB_XGEN(b.x)], 1u);
            asm volatile("s_waitcnt vmcnt(0)" ::: "memory");
        } else {
            XB_SPIN(xb_ld(&bar[XB_XGEN(b.x)]) == gen, bar);
            __builtin_amdgcn_fence(__ATOMIC_ACQUIRE, "agent");
            asm volatile("s_waitcnt vmcnt(0)" ::: "memory");
        }
    }
    __syncthreads();
}

constexpr int PH_PER_LAYER = 11, N_PHASES = 1 + 2 * PH_PER_LAYER;

__device__ __forceinline__ void phase_digest(const Params& p, int wv) {
    const bf16_t* mix = (const bf16_t*)(wsp(p) + WS_MIX); const bf16_t* kc = (const bf16_t*)(wsp(p) + WS_KCMP); const bf16_t* hp = (const bf16_t*)(wsp(p) + WS_HP);
    for (size_t i = (size_t)blockIdx.x * 512 + tidx(wv); i < (size_t)TOK * DM; i += (size_t)gridDim.x * 512) {
        const size_t row = i >> 10; const int col = (int)(i & 1023);
#if defined(MK_DIGEST) && MK_DIGEST == 1
        outp(p)[i] = (((MK_DSEL & 1) && col < 256) || ((MK_DSEL & 2) && col >= 256 && col < 512) ? bf2f(mix[i]) : 0.f) + ((MK_DSEL & 4) ? bf2f(kc[i & (2 * 16 * 256 * 64 - 1)]) : 0.f);
#else
        outp(p)[i] = bf2f(hp[row * NPROJ + col]) + bf2f(hp[row * NPROJ + 1024 + col]) + (col < 768 ? bf2f(hp[row * NPROJ + 2048 + col]) : 0.f);
#endif
    }
}
__device__ __forceinline__ void run_phase(const Params& p, const JobTab& jt, int ph, int wv) {
    if (ph == 99) { phase_digest(p, wv); return; }
#ifdef TEST_PH
    if (TEST_PH == 0) { phase_prologue(p, jt, wv); return; }
    const int l = (ph - 1) / PH_PER_LAYER, s = TEST_PH - 1;
#else
    if (ph == 0) { phase_prologue(p, jt, wv); return; }
    const int l = (ph - 1) / PH_PER_LAYER, s = (ph - 1) % PH_PER_LAYER;
#endif
    bf16_t* XB = (bf16_t*)(wsp(p) + WS_XB); bf16_t* HP = (bf16_t*)(wsp(p) + WS_HP); bf16_t* MIX = (bf16_t*)(wsp(p) + WS_MIX);
    switch (s) {
        case 0: case 8: {
            const bf16_t* W = (const bf16_t*)(wsp(p) + WS_GU + (size_t)(l * 2 + (s == 8)) * SZ_GU);
            gm::gemm_phase<5632, 1024>(XB, W, gm::EpiSwiglu{HP}, wv);
        } break;
        case 1: case 9: {
            const bf16_t* W = (const bf16_t*)(wsp(p) + WS_DN + (size_t)(l * 2 + (s == 9)) * SZ_DN);
            gm::gemm_phase<1024, 2816>(HP, W, gm::EpiResid{XB, outp(p), ALPHA, 0.5f}, wv);
        } break;
        case 2: phase_ln<false>(outp(p), XB, pin(p, 4) + l * DM, pin(p, 5) + l * DM, wv); break;
        case 3: gm::gemm_phase<NPROJ, 1024>(XB, (const bf16_t*)(wsp(p) + WS_IN + (size_t)l * SZ_IN), gm::EpiBf16{HP, NPROJ}, wv); break;
        case 4: phase_mixA(p, l, wv); break;
        case 5: at::phase_attn(p, l, wv); break;
        case 6: gm::gemm_phase<1024, 1024>(MIX, (const bf16_t*)(wsp(p) + WS_OUT + (size_t)l * SZ_OUT), gm::EpiResid{XB, outp(p), ALPHA, 1.0f}, wv); break;
        case 7: phase_ln<false>(outp(p), XB, pin(p, 21) + l * DM, pin(p, 22) + l * DM, wv); break;
        case 10: if (l == 0) phase_ln<false>(outp(p), XB, pin(p, 26), pin(p, 27), wv); else phase_ln<true>(outp(p), XB, pin(p, 26) + DM, pin(p, 27) + DM, wv); break;
    }
}

__global__ void __launch_bounds__(512, 2) fwd_megakernel(Params p, JobTab jt) {
    const int wv = __builtin_amdgcn_readfirstlane((int)(threadIdx.x >> 6));
#if MK_MULTI
    for (int ph = p.ph_lo; ph < p.ph_hi; ++ph) run_phase(p, jt, ph, wv);
#else
    cg::grid_group grid = cg::this_grid();
    volatile LAS unsigned* st = (volatile LAS unsigned*)(dyn_lds + XB_ST_OFF);
    if (tidx(wv) == 0) { st[0] = 0u; st[1] = 0u; }
    __syncthreads();
    XcdBarrier xb = xcd_barrier_post((unsigned*)(p.ws + WS_BAR), st, wv);
#pragma unroll 1
    for (int ph = p.ph_lo; ph < p.ph_hi; ++ph) {
        run_phase(p, jt, ph, wv);
        if (ph + 1 < p.ph_hi) { if (p.ph_lo < 0) grid.sync(); else xcd_barrier(xb, wv); }
    }
#endif
}

extern "C" void kernel_launch(void* const* d_in, const int* in_sizes, int n_in, void* d_out, int out_size, void* d_ws, size_t ws_size, hipStream_t stream) {
    static int grid_blocks = 0;
    if (!grid_blocks) {
        int dev = 0, cus = 0, per_cu = 0;
        hipGetDevice(&dev);
        hipDeviceGetAttribute(&cus, hipDeviceAttributeMultiprocessorCount, dev);
        hipFuncSetAttribute((const void*)fwd_megakernel, hipFuncAttributeMaxDynamicSharedMemorySize, LDS_BYTES);
        hipOccupancyMaxActiveBlocksPerMultiprocessor(&per_cu, (const void*)fwd_megakernel, 512, LDS_BYTES);
        if (per_cu < 1) per_cu = 1;
        grid_blocks = cus * per_cu;
        if (ws_size < WS_END) fprintf(stderr, "kernel_launch: workspace too small (%zu < %zu)\n", ws_size, (size_t)WS_END);
    }
    Params p{};
    JobTab jt{};
    for (int i = 0; i < 28; ++i) p.in[i] = (const float*)d_in[i];
    p.out = (float*)d_out; p.ws = (unsigned char*)d_ws;
    {
        unsigned char* ws = (unsigned char*)d_ws;
        int nj = 0, tiles = 0;
        auto add = [&](const float* src, size_t dstoff, int K, int N, int Nsrc, int rowMul, int rowOff, int perm = 1) {
            TJob& j = jt.jobs[nj++]; j.perm = perm; j.pad = 0; j.src = src; j.dst = (bf16_t*)(ws + dstoff); j.K = K; j.N = N; j.Nsrc = Nsrc; j.rowMul = rowMul; j.rowOff = rowOff; j.tileStart = tiles;
            tiles += (K / 64) * (N / 64);
        };
        for (int l = 0; l < 2; ++l) {
            const size_t wgu = (size_t)l * 1024 * 2816, wdn = (size_t)l * 2816 * 1024;
            add(p.in[1] + wgu, WS_GU + (size_t)(l * 2 + 0) * SZ_GU, 1024, 2816, 2816, 256, 0);
            add(p.in[2] + wgu, WS_GU + (size_t)(l * 2 + 0) * SZ_GU, 1024, 2816, 2816, 256, 128);
            add(p.in[3] + wdn, WS_DN + (size_t)(l * 2 + 0) * SZ_DN, 2816, 1024, 1024, 128, 0);
            add(p.in[6] + (size_t)l * 1024 * NPROJ_SRC, WS_IN + (size_t)l * SZ_IN, 1024, 2816, NPROJ_SRC, 128, 0);
            add(p.in[20] + (size_t)l * 1024 * 1024, WS_OUT + (size_t)l * SZ_OUT, 1024, 1024, 1024, 128, 0);
            add(p.in[23] + wgu, WS_GU + (size_t)(l * 2 + 1) * SZ_GU, 1024, 2816, 2816, 256, 0);
            add(p.in[24] + wgu, WS_GU + (size_t)(l * 2 + 1) * SZ_GU, 1024, 2816, 2816, 256, 128);
            add(p.in[25] + wdn, WS_DN + (size_t)(l * 2 + 1) * SZ_DN, 2816, 1024, 1024, 128, 0);
            add(p.in[13] + (size_t)l * 2048 * 128, WS_C1 + (size_t)(l * 2 + 0) * 128 * 2048 * 2, 2048, 128, 128, 128, 0, 0);
            add(p.in[17] + (size_t)l * 2048 * 128, WS_C1 + (size_t)(l * 2 + 1) * 128 * 2048 * 2, 2048, 128, 128, 128, 0, 0);
            add(p.in[15] + (size_t)l * 128 * 64, WS_C2 + (size_t)(l * 2 + 0) * 64 * 128 * 2, 128, 64, 64, 128, 0, 0);
            add(p.in[19] + (size_t)l * 128 * 64, WS_C2 + (size_t)(l * 2 + 1) * 64 * 128 * 2, 128, 64, 64, 128, 0, 0);
        }
        p.ntiles_total = tiles;
    }
#if MK_MULTI
    for (int ph = 0; ph < (MK_STOP < N_PHASES ? MK_STOP : N_PHASES); ++ph) {
        p.ph_lo = ph; p.ph_hi = ph + 1;
        hipLaunchKernelGGL(fwd_megakernel, dim3(grid_blocks), dim3(512), LDS_BYTES, stream, p, jt);
    }
#ifdef MK_DIGEST
    p.ph_lo = 99; p.ph_hi = 100; hipLaunchKernelGGL(fwd_megakernel, dim3(grid_blocks), dim3(512), LDS_BYTES, stream, p, jt);
#endif
#else
    p.ph_lo = 0; p.ph_hi = (MK_STOP < N_PHASES ? MK_STOP : N_PHASES);
    (void)hipMemsetAsync((unsigned char*)d_ws + WS_BAR, 0, 16384, stream);
    void* args[] = {&p, &jt};
    hipError_t e = hipLaunchCooperativeKernel((const void*)fwd_megakernel, dim3(grid_blocks), dim3(512), args, LDS_BYTES, stream);
    if (e != hipSuccess) fprintf(stderr, "cooperative launch failed: %s (grid %d)\n", hipGetErrorString(e), grid_blocks);
#endif
}
```

```cpp
#include <hip/hip_runtime.h>
#include <hip/hip_cooperative_groups.h>
#include <cstdio>
#include <cstdint>
namespace cg = cooperative_groups;

typedef unsigned short bf16_t;
typedef short bf16x8 __attribute__((ext_vector_type(8)));
typedef float f32x4 __attribute__((ext_vector_type(4)));
typedef unsigned u32x4 __attribute__((ext_vector_type(4)));
typedef unsigned u32x2 __attribute__((ext_vector_type(2)));

#ifndef MK_DSEL
#define MK_DSEL 4
#endif
#ifndef MK_DCOL
#define MK_DCOL 512
#endif
#ifndef MK_STOP
#define MK_STOP 1000
#endif
#ifndef MK_MULTI
#define MK_MULTI 0
#endif

constexpr int BATCH = 8, SEQ = 4096, DM = 1024, TOK = BATCH * SEQ, DFF = 2816, NPROJ = 2816, NPROJ_SRC = 2584;
constexpr int C_HA = 0, C_BA = 256, C_CA = 512, C_U = 768, C_V = 1024, C_Q = 1280, C_KC = 1792, C_VC = 1920, C_KS = 2048, C_VS = 2176,
              C_KW = 2304, C_VW = 2432, C_GL = 2560;
constexpr float ALPHA = 1.41421356237f;
constexpr float LN_EPS = 1e-5f;
constexpr int XB_ST_OFF = 4 * 16384 + 65536 + 512;
constexpr int LDS_BYTES = XB_ST_OFF + 16;

constexpr size_t SZ_GU = (size_t)5632 * 1024 * 2, SZ_DN = (size_t)1024 * 2816 * 2, SZ_IN = (size_t)2816 * 1024 * 2, SZ_OUT = (size_t)1024 * 1024 * 2;
constexpr size_t WS_GU = 0;
constexpr size_t WS_DN = WS_GU + 4 * SZ_GU;
constexpr size_t WS_IN = WS_DN + 4 * SZ_DN;
constexpr size_t WS_OUT = WS_IN + 2 * SZ_IN;
constexpr size_t WS_GM = WS_OUT + 2 * SZ_OUT;
constexpr size_t WS_C1 = WS_GM + (size_t)2 * 4 * 128 * 128 * 2;
constexpr size_t WS_C2 = WS_C1 + (size_t)2 * 2 * 128 * 2048 * 2;
constexpr size_t WS_B1 = WS_C2 + (size_t)2 * 2 * 64 * 128 * 2;
constexpr size_t WS_XB = WS_B1 + 4096;
constexpr size_t WS_HP = WS_XB + (size_t)TOK * 1024 * 2;
constexpr size_t WS_MIX = WS_HP + (size_t)TOK * 2816 * 2;
constexpr size_t WS_KCMP = WS_MIX + (size_t)TOK * 1024 * 2;
constexpr size_t WS_VT = WS_KCMP + (size_t)2 * 16 * 256 * 64 * 2;
constexpr size_t WS_BAR = WS_VT + (size_t)2 * 16 * 64 * SEQ * 2;
constexpr size_t WS_END = WS_BAR + 16384;

struct TJob { const float* src; bf16_t* dst; int K, N, Nsrc, rowMul, rowOff, tileStart, perm, pad; };
constexpr int NJOBS = 24;
struct Params {
    const float* in[28];
    float* out;
    unsigned char* ws;
    int ntiles_total;
    int ph_lo, ph_hi, pad0;
};
struct JobTab { TJob jobs[NJOBS]; };
__device__ __forceinline__ unsigned char* wsp(const Params& p) { long z; asm volatile("s_mov_b64 %0, 0" : "=s"(z)); return p.ws + z; }
__device__ __forceinline__ float* outp(const Params& p) { long z; asm volatile("s_mov_b64 %0, 0" : "=s"(z)); return p.out + z; }
__device__ __forceinline__ const float* pin(const Params& p, int k) { int z; asm volatile("s_mov_b32 %0, 0" : "=s"(z)); return p.in[k + z]; }

typedef float f32x2_t __attribute__((ext_vector_type(2)));
typedef __bf16 bf16x2_t __attribute__((ext_vector_type(2)));
__device__ __forceinline__ unsigned cvt_pk_bf16(float lo, float hi) { f32x2_t v = {lo, hi}; bf16x2_t b = __builtin_convertvector(v, bf16x2_t); return __builtin_bit_cast(unsigned, b); }
__device__ __forceinline__ bf16_t f2bf(float f) { return (bf16_t)(cvt_pk_bf16(f, 0.f) & 0xffffu); }
__device__ __forceinline__ float bf2f(unsigned h) { return __uint_as_float(h << 16); }
__device__ __forceinline__ float bflo(unsigned w) { return __uint_as_float(w << 16); }
__device__ __forceinline__ float bfhi(unsigned w) { return __uint_as_float(w & 0xffff0000u); }
__device__ __forceinline__ float fast_rcp(float x) { return __builtin_amdgcn_rcpf(x); }
__device__ __forceinline__ float fexp2(float x) { return __builtin_amdgcn_exp2f(x); }
__device__ __forceinline__ float sigmoidf_(float x) { return fast_rcp(1.f + fexp2(-1.44269504089f * x)); }
__device__ __forceinline__ float siluf_(float x) { return x * sigmoidf_(x); }
__device__ __forceinline__ float gelu_tanh(float x) { const float u = 1.59576912161f * (x + 0.044715f * x * x * x); return x * sigmoidf_(u); }
__device__ __forceinline__ float shx(float v, int mask, int lane) { return __int_as_float(__builtin_amdgcn_ds_bpermute((lane ^ mask) << 2, __float_as_int(v))); }
__device__ __forceinline__ float wave_sum(float v, int lane) {
#pragma unroll
    for (int o = 1; o < 64; o <<= 1) v += shx(v, o, lane);
    return v;
}

extern __shared__ __attribute__((aligned(16))) unsigned char dyn_lds[];
__device__ __forceinline__ int bidx() { int b = blockIdx.x; asm volatile("" : "+s"(b)); return b; }
__device__ __forceinline__ int gdim() { int g = gridDim.x; asm volatile("" : "+s"(g)); return g; }
__device__ __forceinline__ int tidx(int wv) { int lane; asm volatile("v_mbcnt_lo_u32_b32 %0, -1, 0\n\tv_mbcnt_hi_u32_b32 %0, -1, %0" : "=v"(lane)); return wv * 64 + lane; }

struct TTile { f32x4 v0, v1; };
__device__ __forceinline__ void transpose_load(const TJob& jb, int tile, int tid, TTile& r) {
    const int ntn = jb.N >> 6, tk = tile / ntn, tn = tile - tk * ntn, k0 = tk * 64, n0 = tn * 64;
    const int k = tid >> 4, n4 = (tid & 15) * 4;
    r.v0 = (f32x4){0.f, 0.f, 0.f, 0.f}; r.v1 = r.v0;
    if (n0 + n4 < jb.Nsrc) { r.v0 = *(const f32x4*)(jb.src + (size_t)(k0 + k) * jb.Nsrc + n0 + n4); r.v1 = *(const f32x4*)(jb.src + (size_t)(k0 + k + 32) * jb.Nsrc + n0 + n4); }
}
__device__ __forceinline__ void transpose_store(const TJob& jb, int tile, int tid, const TTile& r) {
    bf16_t* s = (bf16_t*)dyn_lds;
    const int ntn = jb.N >> 6, tk = tile / ntn, tn = tile - tk * ntn, k0 = tk * 64, n0 = tn * 64;
    {
        const int k = tid >> 4, n4 = (tid & 15) * 4;
        s[(n4 + 0) * 72 + k] = f2bf(r.v0[0]); s[(n4 + 1) * 72 + k] = f2bf(r.v0[1]); s[(n4 + 2) * 72 + k] = f2bf(r.v0[2]); s[(n4 + 3) * 72 + k] = f2bf(r.v0[3]);
        s[(n4 + 0) * 72 + k + 32] = f2bf(r.v1[0]); s[(n4 + 1) * 72 + k + 32] = f2bf(r.v1[1]); s[(n4 + 2) * 72 + k + 32] = f2bf(r.v1[2]); s[(n4 + 3) * 72 + k + 32] = f2bf(r.v1[3]);
    }
    __syncthreads();
    {
        const int n = tid >> 3, k8 = (tid & 7) * 8;
        const u32x4 w = *(const u32x4*)(s + n * 72 + k8);
        const int ng = n0 + n; int c128 = ng & 127;
        if (jb.perm) { const int c32 = c128 & 31; c128 = (c128 & 96) + ((c32 >> 2) & 1) * 16 + (c32 >> 3) * 4 + (c32 & 3); }
        const int drow = (ng >> 7) * jb.rowMul + c128 + jb.rowOff;
        *(u32x4*)(jb.dst + (size_t)drow * jb.K + k0 + k8) = w;
    }
    __syncthreads();
}

__device__ __forceinline__ void phase_prologue(const Params& p, const JobTab& jt, int wv) {
    const int tid = tidx(wv), G = gdim();
    {
        auto find_job = [&](int t) { int j = 0;
#pragma unroll 1
            for (int q = 1; q < NJOBS; ++q) if (t >= jt.jobs[q].tileStart) j = q;
            return j; };
        int t = bidx();
        TTile cur, nxt;
        int j = 0;
        if (t < p.ntiles_total) { j = find_job(t); transpose_load(jt.jobs[j], t - jt.jobs[j].tileStart, tid, cur); }
        while (t < p.ntiles_total) {
            const int tn = t + G; int jn = 0;
            if (tn < p.ntiles_total) { jn = find_job(tn); transpose_load(jt.jobs[jn], tn - jt.jobs[jn].tileStart, tid, nxt); }
            transpose_store(jt.jobs[j], t - jt.jobs[j].tileStart, tid, cur);
            cur = nxt; t = tn; j = jn;
        }
    }
    {
        const float* x = pin(p, 0); bf16_t* xb = (bf16_t*)(wsp(p) + WS_XB);
        const size_t n8 = (size_t)TOK * DM / 8;
        for (size_t i = (size_t)bidx() * 512 + tid; i < n8; i += (size_t)G * 512) {
            const f32x4 a = *(const f32x4*)(x + i * 8), b = *(const f32x4*)(x + i * 8 + 4);
            u32x4 w; w.x = cvt_pk_bf16(a[0], a[1]); w.y = cvt_pk_bf16(a[2], a[3]); w.z = cvt_pk_bf16(b[0], b[1]); w.w = cvt_pk_bf16(b[2], b[3]);
            *(u32x4*)(xb + i * 8) = w;
        }
    }
    {
        const float* w = pin(p, 10); bf16_t* o = (bf16_t*)(wsp(p) + WS_GM);
        for (int i = bidx() * 512 + tid; i < 2 * 4 * 128 * 128; i += G * 512) { const int q = i & 127, pp = (i >> 7) & 127; o[i] = (q <= pp) ? f2bf(w[i]) : (bf16_t)0; }
    }
    if (bidx() < 4) {
        const int l = bidx() >> 1, kv = bidx() & 1;
        const float* pe = pin(p, kv ? 16 : 12) + (size_t)l * 2048;
        const float* w1 = pin(p, kv ? 17 : 13) + (size_t)l * 2048 * 128;
        const float* b1 = pin(p, kv ? 18 : 14) + (size_t)l * 128;
        float* red = (float*)dyn_lds;
        const int f = tid & 127, part = tid >> 7;
        float s = 0.f;
        for (int k = part * 512; k < part * 512 + 512; ++k) s += pe[k] * w1[(size_t)k * 128 + f];
        red[tid] = s;
        __syncthreads();
        if (tid < 128) ((float*)(wsp(p) + WS_B1))[(l * 2 + kv) * 128 + tid] = b1[tid] + red[tid] + red[tid + 128] + red[tid + 256] + red[tid + 384];
        __syncthreads();
    }
}

namespace gm {
constexpr int BM = 256, BK = 64, HALF = 128, NXCD = 8, WGM = 8, HT = HALF * BK;
__device__ __forceinline__ int lds_byte(int r, int c) { int st = (r >> 4) * 2 + (c >> 5), rr = r & 15, cc = c & 31, ob = rr * 64 + cc * 2; return st * 1024 + (ob ^ (((ob >> 9) & 1) << 5)); }
__device__ __forceinline__ void stage_rc(int b, int& R, int& C) { int st = b / 1024, sb = b % 1024, swz = sb ^ (((sb >> 9) & 1) << 5); R = (st >> 1) * 16 + swz / 64; C = (st & 1) * 32 + (swz % 64) / 2; }

struct EpiSwiglu {
    bf16_t* H;
    __device__ __forceinline__ void operator()(const f32x4 (&acc)[2][2][4][2], int brow, int pn, int wr, int wc, int fr, int fq) const {
#pragma unroll
        for (int ai = 0; ai < 2; ++ai)
#pragma unroll
            for (int m = 0; m < 4; ++m) {
                const int row = brow + ai * HALF + wr * 64 + m * 16 + fr;
                const f32x4 g0 = acc[ai][0][m][0], u0 = acc[ai][1][m][0], g1 = acc[ai][0][m][1], u1 = acc[ai][1][m][1];
                u32x4 w;
                w.x = cvt_pk_bf16(siluf_(g0[0]) * u0[0], siluf_(g0[1]) * u0[1]); w.y = cvt_pk_bf16(siluf_(g0[2]) * u0[2], siluf_(g0[3]) * u0[3]);
                w.z = cvt_pk_bf16(siluf_(g1[0]) * u1[0], siluf_(g1[1]) * u1[1]); w.w = cvt_pk_bf16(siluf_(g1[2]) * u1[2], siluf_(g1[3]) * u1[3]);
                *(u32x4*)(H + (size_t)row * DFF + pn * 128 + wc * 32 + fq * 8) = w;
            }
    }
};
struct EpiResid {
    const bf16_t* res; float* out; float sa, sb;
    __device__ __forceinline__ void operator()(const f32x4 (&acc)[2][2][4][2], int brow, int pn, int wr, int wc, int fr, int fq) const {
#pragma unroll
        for (int ai = 0; ai < 2; ++ai)
#pragma unroll
            for (int m = 0; m < 4; ++m) {
                const int row = brow + ai * HALF + wr * 64 + m * 16 + fr;
#pragma unroll
                for (int bj = 0; bj < 2; ++bj) {
                    const size_t off = (size_t)row * DM + pn * BM + bj * HALF + wc * 32 + fq * 8;
                    const u32x4 rw = *(const u32x4*)(res + off);
                    const f32x4 r0 = {bflo(rw.x), bfhi(rw.x), bflo(rw.y), bfhi(rw.y)}, r1 = {bflo(rw.z), bfhi(rw.z), bflo(rw.w), bfhi(rw.w)};
                    *(f32x4*)(out + off) = r0 * sa + acc[ai][bj][m][0] * sb;
                    *(f32x4*)(out + off + 4) = r1 * sa + acc[ai][bj][m][1] * sb;
                }
            }
    }
};
struct EpiBf16 {
    bf16_t* O; int ld;
    __device__ __forceinline__ void operator()(const f32x4 (&acc)[2][2][4][2], int brow, int pn, int wr, int wc, int fr, int fq) const {
#pragma unroll
        for (int ai = 0; ai < 2; ++ai)
#pragma unroll
            for (int m = 0; m < 4; ++m) {
                const int row = brow + ai * HALF + wr * 64 + m * 16 + fr;
#pragma unroll
                for (int bj = 0; bj < 2; ++bj) {
                    const f32x4 v0 = acc[ai][bj][m][0], v1 = acc[ai][bj][m][1];
                    u32x4 w; w.x = cvt_pk_bf16(v0[0], v0[1]); w.y = cvt_pk_bf16(v0[2], v0[3]); w.z = cvt_pk_bf16(v1[0], v1[1]); w.w = cvt_pk_bf16(v1[2], v1[3]);
                    *(u32x4*)(O + (size_t)row * ld + pn * BM + bj * HALF + wc * 32 + fq * 8) = w;
                }
            }
    }
};

#define SA(b, h) (shm + ((b) * 2 + (h)) * HT)
#define SB(b, h) (shm + (4 + (b) * 2 + (h)) * HT)
#define STAGE(P, BASE, br, kt) do { const bf16_t* _ub = (BASE) + __builtin_amdgcn_readfirstlane((br) * K + (kt) * BK); \
    __builtin_amdgcn_global_load_lds((const unsigned*)((const char*)_ub + voff0), (unsigned*)((char*)(P) + tid16), 16, 0, 0); \
    __builtin_amdgcn_global_load_lds((const unsigned*)((const char*)_ub + voff1), (unsigned*)((char*)(P) + tid16 + 8192), 16, 0, 0); } while (0)
#define LDA(dst, b, h) for (int m = 0; m < 4; ++m) for (int k = 0; k < 2; ++k) \
    dst[m][k] = *reinterpret_cast<const bf16x8*>((char*)SA(b, h) + lds_byte(wr * 64 + m * 16 + fr, k * 32 + fq * 8))
#define LDB(dst, b, h) for (int n = 0; n < 2; ++n) for (int k = 0; k < 2; ++k) \
    dst[n][k] = *reinterpret_cast<const bf16x8*>((char*)SB(b, h) + lds_byte(wc * 32 + n * 16 + fr, k * 32 + fq * 8))
#define MMA(ai, bj, At, Bt_) do { __builtin_amdgcn_s_setprio(1); \
    for (int m = 0; m < 4; ++m) for (int n = 0; n < 2; ++n) for (int k = 0; k < 2; ++k) \
      acc[ai][bj][m][n] = __builtin_amdgcn_mfma_f32_16x16x32_bf16(Bt_[n][k], At[m][k], acc[ai][bj][m][n], 0, 0, 0); \
    __builtin_amdgcn_s_setprio(0); } while (0)
#define WAIT_V(n) asm volatile("s_waitcnt vmcnt(" #n ")" ::: "memory")
#define WAIT_L(n) asm volatile("s_waitcnt lgkmcnt(" #n ")" ::: "memory")
#define BAR __builtin_amdgcn_s_barrier()
#define SCHED __builtin_amdgcn_sched_barrier(0)

template <int N, int K, class Epi>
__device__ __forceinline__ void gemm_phase(const bf16_t* __restrict__ A, const bf16_t* __restrict__ Bt, const Epi& epi, int wv) {
    constexpr int M = TOK;
    bf16_t* shm = (bf16_t*)dyn_lds;
    constexpr int nM = M / BM, nN = N / BM, nwg = nM * nN; const int G = gdim();
    static_assert(nwg % NXCD == 0 && nM % WGM == 0, "tile map assumes these");
    const int tidg = tidx(wv);
    const int wid = tidg >> 6, lane = tidg & 63, wr = wid >> 2, wc = wid & 3, fr = lane & 15, fq = lane >> 4;
    constexpr int nt = K / BK;
    const int tid16 = tidg * 16;
    unsigned voff0, voff1;
    { int _r, _c; stage_rc(tid16, _r, _c); voff0 = (unsigned)(_r * K + _c) * 2u; stage_rc(tid16 + 8192, _r, _c); voff1 = (unsigned)(_r * K + _c) * 2u; }
    long L = bidx();
    if (L >= nwg) return;
    int brow, bcol, pn;
#define TILE_COORDS() do { int wgid = (int)L; wgid = (wgid % NXCD) * (nwg / NXCD) + wgid / NXCD; \
        constexpr int nig = WGM * nN; const int gid = wgid / nig, wl = wgid - gid * nig; \
        const int pm = gid * WGM + (wl % WGM); pn = wl / WGM; brow = pm * BM; bcol = pn * BM; } while (0)
    TILE_COORDS();
    STAGE(SB(0, 0), Bt, bcol, 0); STAGE(SA(0, 0), A, brow, 0);
    STAGE(SB(0, 1), Bt, bcol + HALF, 0); STAGE(SA(0, 1), A, brow + HALF, 0);
#pragma unroll 1
    for (;;) {
        f32x4 acc[2][2][4][2] = {};
        bf16x8 At[4][2], B0[2][2], B1[2][2];
        if (wr == 1) BAR;
        WAIT_V(4); BAR;
        STAGE(SB(1, 0), Bt, bcol, 1); STAGE(SA(1, 0), A, brow, 1); STAGE(SB(1, 1), Bt, bcol + HALF, 1);
        WAIT_V(6); BAR;
#pragma unroll 1
        for (int t = 0; t < nt - 2; t += 2) {
            LDB(B0, 0, 0); SCHED; LDA(At, 0, 0); STAGE(SA(1, 1), A, brow + HALF, t + 1);
            WAIT_L(8); BAR; WAIT_L(0); MMA(0, 0, At, B0); BAR; SCHED;
            LDB(B1, 0, 1); STAGE(SB(0, 0), Bt, bcol, t + 2);
            BAR; WAIT_L(0); MMA(0, 1, At, B1); BAR;
            LDA(At, 0, 1); STAGE(SA(0, 0), A, brow, t + 2);
            BAR; WAIT_L(0); MMA(1, 0, At, B0); BAR; SCHED;
            STAGE(SB(0, 1), Bt, bcol + HALF, t + 2);
            WAIT_V(6); BAR; MMA(1, 1, At, B1); BAR;
            LDB(B0, 1, 0); SCHED; LDA(At, 1, 0); STAGE(SA(0, 1), A, brow + HALF, t + 2);
            WAIT_L(8); BAR; WAIT_L(0); MMA(0, 0, At, B0); BAR; SCHED;
            LDB(B1, 1, 1); STAGE(SB(1, 0), Bt, bcol, t + 3);
            BAR; WAIT_L(0); MMA(0, 1, At, B1); BAR;
            LDA(At, 1, 1); STAGE(SA(1, 0), A, brow, t + 3);
            BAR; WAIT_L(0); MMA(1, 0, At, B0); BAR; SCHED;
            STAGE(SB(1, 1), Bt, bcol + HALF, t + 3);
            WAIT_V(6); BAR; MMA(1, 1, At, B1); BAR;
        }
        { LDB(B0, 0, 0); LDA(At, 0, 0); STAGE(SA(1, 1), A, brow + HALF, nt - 1);
          BAR; WAIT_L(0); MMA(0, 0, At, B0); BAR;
          LDB(B1, 0, 1); BAR; WAIT_L(0); MMA(0, 1, At, B1); BAR;
          LDA(At, 0, 1); WAIT_V(4); BAR; WAIT_L(0); MMA(1, 0, At, B0); MMA(1, 1, At, B1); BAR; }
        { LDB(B0, 1, 0); LDA(At, 1, 0); WAIT_V(2); BAR; WAIT_L(0); MMA(0, 0, At, B0); BAR;
          LDB(B1, 1, 1); WAIT_V(0); BAR; WAIT_L(0); MMA(0, 1, At, B1); BAR;
          LDA(At, 1, 1); BAR; WAIT_L(0); MMA(1, 0, At, B0); MMA(1, 1, At, B1); BAR; }
        if (wr == 0) BAR;
        const int cbrow = brow, cpn = pn;
        L += G;
        const bool more = L < nwg;
        if (more) {
            TILE_COORDS();
            STAGE(SB(0, 0), Bt, bcol, 0); STAGE(SA(0, 0), A, brow, 0);
            STAGE(SB(0, 1), Bt, bcol + HALF, 0); STAGE(SA(0, 1), A, brow + HALF, 0);
        }
        epi(acc, cbrow, cpn, wr, wc, fr, fq);
        if (!more) break;
    }
    WAIT_V(0);
#undef TILE_COORDS
}
#undef SA
#undef SB
#undef STAGE
#undef LDA
#undef LDB
#undef MMA
}

template <bool FINAL>
__device__ __forceinline__ void phase_ln(float* y, bf16_t* xb, const float* g, const float* bta, int wv) {
    const int tidl = tidx(wv);
    const int wid = tidl >> 6, lane = tidl & 63;
    const int gw = bidx() * 8 + wid, NW = gdim() * 8;
    f32x4 gv[4], bv[4];
#pragma unroll
    for (int j = 0; j < 4; ++j) { gv[j] = *(const f32x4*)(g + j * 256 + lane * 4); bv[j] = *(const f32x4*)(bta + j * 256 + lane * 4); }
    for (int row = gw; row < TOK; row += 2 * NW) {
        const bool two = row + NW < TOK;
        float* yr0 = y + (size_t)row * DM;
        float* yr1 = y + (size_t)(two ? row + NW : row) * DM;
        f32x4 v0[4], v1[4]; float s0 = 0.f, s1 = 0.f;
#pragma unroll
        for (int j = 0; j < 4; ++j) { v0[j] = *(const f32x4*)(yr0 + j * 256 + lane * 4); v1[j] = *(const f32x4*)(yr1 + j * 256 + lane * 4); }
#pragma unroll
        for (int j = 0; j < 4; ++j) { s0 += (v0[j][0] + v0[j][1]) + (v0[j][2] + v0[j][3]); s1 += (v1[j][0] + v1[j][1]) + (v1[j][2] + v1[j][3]); }
        const float mean0 = wave_sum(s0, lane) * (1.f / DM), mean1 = wave_sum(s1, lane) * (1.f / DM);
        float q0 = 0.f, q1 = 0.f;
#pragma unroll
        for (int j = 0; j < 4; ++j) {
            v0[j] = v0[j] - mean0; q0 += (v0[j][0] * v0[j][0] + v0[j][1] * v0[j][1]) + (v0[j][2] * v0[j][2] + v0[j][3] * v0[j][3]);
            v1[j] = v1[j] - mean1; q1 += (v1[j][0] * v1[j][0] + v1[j][1] * v1[j][1]) + (v1[j][2] * v1[j][2] + v1[j][3] * v1[j][3]);
        }
        const float rstd0 = rsqrtf(wave_sum(q0, lane) * (1.f / DM) + LN_EPS), rstd1 = rsqrtf(wave_sum(q1, lane) * (1.f / DM) + LN_EPS);
#pragma unroll
        for (int j = 0; j < 4; ++j) {
            const f32x4 o0 = v0[j] * rstd0 * gv[j] + bv[j], o1 = v1[j] * rstd1 * gv[j] + bv[j];
            if (FINAL) { *(f32x4*)(yr0 + j * 256 + lane * 4) = o0; if (two) *(f32x4*)(yr1 + j * 256 + lane * 4) = o1; }
            else {
                u32x2 w; w.x = cvt_pk_bf16(o0[0], o0[1]); w.y = cvt_pk_bf16(o0[2], o0[3]); *(u32x2*)(xb + (size_t)row * DM + j * 256 + lane * 4) = w;
                if (two) { u32x2 w1; w1.x = cvt_pk_bf16(o1[0], o1[1]); w1.y = cvt_pk_bf16(o1[2], o1[3]); *(u32x2*)(xb + (size_t)(row + NW) * DM + j * 256 + lane * 4) = w1; }
            }
        }
    }
}

__device__ __forceinline__ void gmlp_unit(const Params& p, int l, int chunk, int wv) {
    const bf16_t* proj = (const bf16_t*)(wsp(p) + WS_HP);
    bf16_t* mix = (bf16_t*)(wsp(p) + WS_MIX);
    bf16_t* vT = (bf16_t*)dyn_lds;
    const int tid = tidx(wv), wid = tid >> 6, lane = tid & 63, fr = lane & 15, fq = lane >> 4;
    const size_t tok0 = (size_t)chunk * 128;
    {
        const f32x4 gg = *(const f32x4*)(pin(p, 8) + l * 256 + lane * 4), bb = *(const f32x4*)(pin(p, 9) + l * 256 + lane * 4);
#pragma unroll 4
        for (int i = 0; i < 16; ++i) {
            const int q = wid * 16 + i;
            const u32x2 w = *(const u32x2*)(proj + (tok0 + q) * NPROJ + C_V + lane * 4);
            float z0 = gelu_tanh(bflo(w.x)), z1 = gelu_tanh(bfhi(w.x)), z2 = gelu_tanh(bflo(w.y)), z3 = gelu_tanh(bfhi(w.y));
            const float mean = wave_sum((z0 + z1) + (z2 + z3), lane) * (1.f / 256.f);
            z0 -= mean; z1 -= mean; z2 -= mean; z3 -= mean;
            const float rstd = rsqrtf(wave_sum((z0 * z0 + z1 * z1) + (z2 * z2 + z3 * z3), lane) * (1.f / 256.f) + LN_EPS);
            vT[(lane * 4 + 0) * 136 + q] = f2bf(z0 * rstd * gg[0] + bb[0]);
            vT[(lane * 4 + 1) * 136 + q] = f2bf(z1 * rstd * gg[1] + bb[1]);
            vT[(lane * 4 + 2) * 136 + q] = f2bf(z2 * rstd * gg[2] + bb[2]);
            vT[(lane * 4 + 3) * 136 + q] = f2bf(z3 * rstd * gg[3] + bb[3]);
        }
    }
    __syncthreads();
    const int h = wid >> 1, pbase = (wid & 1) * 64;
    const bf16_t* W = (const bf16_t*)(wsp(p) + WS_GM) + ((size_t)(l * 4 + h) * 128) * 128;
    f32x4 acc[4][4] = {};
#pragma unroll
    for (int ks = 0; ks < 4; ++ks) {
        bf16x8 wf[4], vf[4];
#pragma unroll
        for (int pt = 0; pt < 4; ++pt) wf[pt] = *(const bf16x8*)(W + (size_t)(pbase + pt * 16 + fr) * 128 + ks * 32 + fq * 8);
#pragma unroll
        for (int dt = 0; dt < 4; ++dt) vf[dt] = *(const bf16x8*)(vT + (h * 64 + dt * 16 + fr) * 136 + ks * 32 + fq * 8);
#pragma unroll
        for (int pt = 0; pt < 4; ++pt)
#pragma unroll
            for (int dt = 0; dt < 4; ++dt) acc[pt][dt] = __builtin_amdgcn_mfma_f32_16x16x32_bf16(vf[dt], wf[pt], acc[pt][dt], 0, 0, 0);
    }
#pragma unroll
    for (int pt = 0; pt < 4; ++pt) {
        const int pp = pbase + pt * 16 + fr;
        const float bs = pin(p, 11)[(l * 4 + h) * 128 + pp];
#pragma unroll
        for (int dt = 0; dt < 4; ++dt) {
            const int col = h * 64 + dt * 16 + fq * 4;
            const u32x2 uw = *(const u32x2*)(proj + (tok0 + pp) * NPROJ + C_U + col);
            const f32x4 a = acc[pt][dt];
            u32x2 w; w.x = cvt_pk_bf16(gelu_tanh(bflo(uw.x)) * (a[0] + bs), gelu_tanh(bfhi(uw.x)) * (a[1] + bs));
            w.y = cvt_pk_bf16(gelu_tanh(bflo(uw.y)) * (a[2] + bs), gelu_tanh(bfhi(uw.y)) * (a[3] + bs));
            *(u32x2*)(mix + (tok0 + pp) * DM + 256 + col) = w;
        }
    }
    __syncthreads();
}

__device__ __forceinline__ void compress_unit(const Params& p, int l, int unit, int wv) {
    const int nt = unit & 15, bg = (unit >> 4) & 15, kv = unit >> 8, b = bg >> 1, g = bg & 1;
    const bf16_t* proj = (const bf16_t*)(wsp(p) + WS_HP);
    const bf16_t* W1 = (const bf16_t*)(wsp(p) + WS_C1) + (size_t)(l * 2 + kv) * 128 * 2048;
    const bf16_t* W2 = (const bf16_t*)(wsp(p) + WS_C2) + (size_t)(l * 2 + kv) * 64 * 128;
    const float* b1f = (const float*)(wsp(p) + WS_B1) + (l * 2 + kv) * 128;
    bf16_t* outp = (bf16_t*)(wsp(p) + WS_KCMP) + ((size_t)(kv * 16 + bg) * 256) * 64;
    bf16_t* hS = (bf16_t*)dyn_lds;
    const int tid = tidx(wv), wid = tid >> 6, lane = tid & 63, fr = lane & 15, fq = lane >> 4;
    int n = nt * 16 + fr; if (n > 254) n = 254;
    const bf16_t* arow = proj + ((size_t)b * SEQ + 16 * n) * NPROJ + (kv ? C_VC : C_KC) + g * 64 + fq * 8;
    const bf16_t* brow = W1 + (size_t)(wid * 16 + fr) * 2048 + fq * 8;
    f32x4 acc = {0.f, 0.f, 0.f, 0.f};
#pragma unroll 16
    for (int kk = 0; kk < 64; ++kk) {
        const bf16x8 a = *(const bf16x8*)(arow + (size_t)(kk >> 1) * NPROJ + (kk & 1) * 32);
        const bf16x8 w = *(const bf16x8*)(brow + kk * 32);
        acc = __builtin_amdgcn_mfma_f32_16x16x32_bf16(a, w, acc, 0, 0, 0);
    }
    {
        const float bias = b1f[wid * 16 + fr];
#pragma unroll
        for (int j = 0; j < 4; ++j) hS[(fq * 4 + j) * 136 + wid * 16 + fr] = f2bf(gelu_tanh(acc[j] + bias));
    }
    __syncthreads();
    if (wid < 4) {
        f32x4 o = {0.f, 0.f, 0.f, 0.f};
#pragma unroll
        for (int ks = 0; ks < 4; ++ks) {
            const bf16x8 hf = *(const bf16x8*)(hS + fr * 136 + ks * 32 + fq * 8);
            const bf16x8 wf = *(const bf16x8*)(W2 + (size_t)(wid * 16 + fr) * 128 + ks * 32 + fq * 8);
            o = __builtin_amdgcn_mfma_f32_16x16x32_bf16(wf, hf, o, 0, 0, 0);
        }
        const int nn = nt * 16 + fr;
        u32x2 w; w.x = cvt_pk_bf16(o[0], o[1]); w.y = cvt_pk_bf16(o[2], o[3]);
        if (nn > 254) { w.x = 0; w.y = 0; }
        if (kv == 0) *(u32x2*)(outp + (size_t)nn * 64 + wid * 16 + fq * 4) = w;
        else {
            const unsigned short e0 = (unsigned short)(w.x & 0xffff), e1 = (unsigned short)(w.x >> 16), e2 = (unsigned short)(w.y & 0xffff), e3 = (unsigned short)(w.y >> 16);
            bf16_t* op = outp + (size_t)(wid * 16 + fq * 4) * 256 + nn;
            op[0] = e0; op[256] = e1; op[512] = e2; op[768] = e3;
        }
    }
    __syncthreads();
}

__device__ __forceinline__ u32x4 vtrans_load(const Params& p, int job, int tid) {
    const int tile = job & 63, bg = (job >> 6) & 15, which = job >> 10, b = bg >> 1, g = bg & 1;
    const bf16_t* src = (const bf16_t*)(wsp(p) + WS_HP) + ((size_t)b * SEQ + tile * 64) * NPROJ + (which ? C_VW : C_VS) + g * 64;
    return *(const u32x4*)(src + (size_t)(tid >> 3) * NPROJ + (tid & 7) * 8);
}
__device__ __forceinline__ void vtrans_store(const Params& p, int job, int tid, const u32x4 v) {
    const int tile = job & 63, bg = (job >> 6) & 15, which = job >> 10;
    bf16_t* dst = (bf16_t*)(wsp(p) + WS_VT) + ((size_t)(which * 16 + bg) * 64) * SEQ + tile * 64;
    bf16_t* s = (bf16_t*)dyn_lds;
    {
        const int tok = tid >> 3, c = tid & 7;
        s[(c * 8 + 0) * 72 + tok] = (bf16_t)(v.x & 0xffff); s[(c * 8 + 1) * 72 + tok] = (bf16_t)(v.x >> 16);
        s[(c * 8 + 2) * 72 + tok] = (bf16_t)(v.y & 0xffff); s[(c * 8 + 3) * 72 + tok] = (bf16_t)(v.y >> 16);
        s[(c * 8 + 4) * 72 + tok] = (bf16_t)(v.z & 0xffff); s[(c * 8 + 5) * 72 + tok] = (bf16_t)(v.z >> 16);
        s[(c * 8 + 6) * 72 + tok] = (bf16_t)(v.w & 0xffff); s[(c * 8 + 7) * 72 + tok] = (bf16_t)(v.w >> 16);
    }
    __syncthreads();
    {
        const int d = tid >> 3, c = tid & 7;
        *(u32x4*)(dst + (size_t)d * SEQ + c * 8) = *(const u32x4*)(s + d * 72 + c * 8);
    }
    __syncthreads();
}
__device__ __forceinline__ void vtrans_all(const Params& p, int wv) {
    const int tid = tidx(wv), G = gdim();
    int u = bidx();
    u32x4 cur = {0u, 0u, 0u, 0u}, nxt = cur;
    if (u < 2048) cur = vtrans_load(p, u, tid);
    while (u < 2048) {
        const int un = u + G;
        if (un < 2048) nxt = vtrans_load(p, un, tid);
        vtrans_store(p, u, tid, cur);
        cur = nxt; u = un;
    }
}

__device__ __forceinline__ void conv_items(const Params& p, int l, int wv) {
    const bf16_t* proj = (const bf16_t*)(wsp(p) + WS_HP);
    bf16_t* mix = (bf16_t*)(wsp(p) + WS_MIX);
    const float* cw = pin(p, 7) + (size_t)l * 3 * 256;
    const int total = TOK * 32;
    for (int idx = bidx() * 512 + tidx(wv); idx < total; idx += gdim() * 512) {
        const int t = idx >> 5, c8 = (idx & 31) * 8, s = t & (SEQ - 1);
        const bf16_t* row = proj + (size_t)t * NPROJ;
        float accv[8] = {0.f, 0.f, 0.f, 0.f, 0.f, 0.f, 0.f, 0.f};
#pragma unroll
        for (int w = 0; w < 3; ++w) {
            if (s - 2 + w >= 0) {
                const bf16_t* r2 = row - (size_t)(2 - w) * NPROJ;
                const u32x4 hh = *(const u32x4*)(r2 + C_HA + c8), cc = *(const u32x4*)(r2 + C_CA + c8);
                const f32x4 k0 = *(const f32x4*)(cw + w * 256 + c8), k1 = *(const f32x4*)(cw + w * 256 + c8 + 4);
                accv[0] += k0[0] * bflo(hh.x) * bflo(cc.x); accv[1] += k0[1] * bfhi(hh.x) * bfhi(cc.x);
                accv[2] += k0[2] * bflo(hh.y) * bflo(cc.y); accv[3] += k0[3] * bfhi(hh.y) * bfhi(cc.y);
                accv[4] += k1[0] * bflo(hh.z) * bflo(cc.z); accv[5] += k1[1] * bfhi(hh.z) * bfhi(cc.z);
                accv[6] += k1[2] * bflo(hh.w) * bflo(cc.w); accv[7] += k1[3] * bfhi(hh.w) * bfhi(cc.w);
            }
        }
        const u32x4 bb = *(const u32x4*)(row + C_BA + c8);
        u32x4 o;
        o.x = cvt_pk_bf16(accv[0] * bflo(bb.x), accv[1] * bfhi(bb.x)); o.y = cvt_pk_bf16(accv[2] * bflo(bb.y), accv[3] * bfhi(bb.y));
        o.z = cvt_pk_bf16(accv[4] * bflo(bb.z), accv[5] * bfhi(bb.z)); o.w = cvt_pk_bf16(accv[6] * bflo(bb.w), accv[7] * bfhi(bb.w));
        *(u32x4*)(mix + (size_t)t * DM + c8) = o;
    }
}

__device__ __forceinline__ void phase_mixA(const Params& p, int l, int wv) {
    const int G = gdim();
    for (int u = bidx(); u < 256; u += G) gmlp_unit(p, l, u, wv);
    for (int u = bidx(); u < 512; u += G) compress_unit(p, l, u, wv);
    vtrans_all(p, wv);
    conv_items(p, l, wv);
}

namespace at {
constexpr float SC = 0.125f * 1.44269504089f;
constexpr float NEGBIG = -1e30f;
constexpr int RD = 4;
constexpr int SLOT = 16384;
constexpr int OFF_IMP = RD * SLOT;
constexpr int OFF_SELM = OFF_IMP + 65536;

struct Stream {
    const bf16_t *kcmp, *vcmpT, *ksel, *vselT, *kwin, *vwinT;
    int n0, nsel, w0, ntot;
};
__device__ __forceinline__ void issue_tile(const Stream& S, int tau, int tid) {
    const bf16_t *kb, *vb; int ldk, ldv;
    if (tau < 2 * S.n0) { const int t = tau < S.n0 ? tau : tau - S.n0; kb = S.kcmp + t * 64 * 64; ldk = 64; vb = S.vcmpT + t * 64; ldv = 256; }
    else if (tau < 2 * S.n0 + S.nsel) { const int t = tau - 2 * S.n0; kb = S.ksel + (size_t)t * 64 * NPROJ; ldk = NPROJ; vb = S.vselT + t * 64; ldv = SEQ; }
    else { const int t = S.w0 + tau - (2 * S.n0 + S.nsel); kb = S.kwin + (size_t)t * 64 * NPROJ; ldk = NPROJ; vb = S.vwinT + t * 64; ldv = SEQ; }
    const int row = tid >> 3, chk = (tid & 7) ^ (((row >> 1) & 1) | (((row >> 3) & 3) << 1)), chv = (tid & 7) ^ ((row >> 1) & 7);
    unsigned char* slot = dyn_lds + (tau & (RD - 1)) * SLOT;
    __builtin_amdgcn_global_load_lds((const unsigned*)(kb + (size_t)row * ldk + chk * 8), (unsigned*)(slot + tid * 16), 16, 0, 0);
    __builtin_amdgcn_global_load_lds((const unsigned*)(vb + (size_t)row * ldv + chv * 8), (unsigned*)(slot + 8192 + tid * 16), 16, 0, 0);
}

template <int MODE, bool MASKED>
__device__ __forceinline__ void tile_compute(const unsigned char* Ks, const unsigned char* Vt, const bf16x8 (&qf)[2][2], f32x4 (&o)[2][4], float (&m)[2], float (&lsum)[2],
                                             const float (&invl)[2], const int (&lo)[2], const int (&hi)[2], const bool (&act)[2], f32x4 (&s)[2][4], int fr, int fq) {
#pragma unroll
    for (int kt = 0; kt < 4; ++kt) {
        const int krow = (kt >> 1) * 32 + (fr >> 2) * 8 + (kt & 1) * 4 + (fr & 3);
        const int ksw = ((krow >> 1) & 1) | (((krow >> 3) & 3) << 1);
        const bf16x8 k0 = *(const bf16x8*)(Ks + krow * 128 + ((fq ^ ksw) << 4)), k1 = *(const bf16x8*)(Ks + krow * 128 + (((4 + fq) ^ ksw) << 4));
#pragma unroll
        for (int grp = 0; grp < 2; ++grp) {
            f32x4 z = {0.f, 0.f, 0.f, 0.f};
            z = __builtin_amdgcn_mfma_f32_16x16x32_bf16(k0, qf[grp][0], z, 0, 0, 0);
            s[grp][kt] = __builtin_amdgcn_mfma_f32_16x16x32_bf16(k1, qf[grp][1], z, 0, 0, 0);
        }
    }
    bf16x8 pf[2][2];
#pragma unroll
    for (int grp = 0; grp < 2; ++grp) {
        float mx = m[grp];
        if (MASKED) {
#pragma unroll
            for (int kt = 0; kt < 4; ++kt)
#pragma unroll
                for (int jj = 0; jj < 4; ++jj) {
                    const int kl = (kt >> 1) * 32 + fq * 8 + (kt & 1) * 4 + jj;
                    const float v = (kl >= lo[grp] && kl <= hi[grp]) ? s[grp][kt][jj] : NEGBIG;
                    s[grp][kt][jj] = v; mx = fmaxf(mx, v);
                }
        } else {
            float t0 = fmaxf(fmaxf(s[grp][0][0], s[grp][0][1]), fmaxf(s[grp][0][2], s[grp][0][3]));
#pragma unroll
            for (int kt = 1; kt < 4; ++kt) t0 = fmaxf(fmaxf(t0, s[grp][kt][0]), fmaxf(fmaxf(s[grp][kt][1], s[grp][kt][2]), s[grp][kt][3]));
            mx = fmaxf(mx, t0);
        }
        float alpha = 1.f;
        if (MODE != 1) {
            mx = fmaxf(mx, shx(mx, 16, fq * 16 + fr)); mx = fmaxf(mx, shx(mx, 32, fq * 16 + fr));
            if (!MASKED) mx = act[grp] ? mx : m[grp];
            alpha = fexp2((m[grp] - mx) * SC); m[grp] = mx;
        } else mx = m[grp];
        const float msc = mx * SC;
        float rs = 0.f;
#pragma unroll
        for (int kt = 0; kt < 4; ++kt)
#pragma unroll
            for (int jj = 0; jj < 4; ++jj) {
                const float v = s[grp][kt][jj];
                float pv = fexp2(__builtin_fmaf(v, SC, -msc));
                if (MASKED) pv = (v > -1e29f) ? pv : 0.f;
                if (MODE == 1) pv *= invl[grp];
                rs += pv; s[grp][kt][jj] = pv;
            }
        if (!MASKED) rs = act[grp] ? rs : 0.f;
        if (MODE != 1) lsum[grp] = lsum[grp] * alpha + rs;
        if (MODE == 2) {
#pragma unroll
            for (int dt = 0; dt < 4; ++dt) o[grp][dt] = o[grp][dt] * alpha;
        }
        if (MODE != 0) {
#pragma unroll
            for (int kk = 0; kk < 2; ++kk) {
                u32x4 w;
                w.x = cvt_pk_bf16(s[grp][2 * kk][0], s[grp][2 * kk][1]); w.y = cvt_pk_bf16(s[grp][2 * kk][2], s[grp][2 * kk][3]);
                w.z = cvt_pk_bf16(s[grp][2 * kk + 1][0], s[grp][2 * kk + 1][1]); w.w = cvt_pk_bf16(s[grp][2 * kk + 1][2], s[grp][2 * kk + 1][3]);
                if (!MASKED) { w.x = act[grp] ? w.x : 0u; w.y = act[grp] ? w.y : 0u; w.z = act[grp] ? w.z : 0u; w.w = act[grp] ? w.w : 0u; }
                pf[grp][kk] = __builtin_bit_cast(bf16x8, w);
            }
        }
    }
    if (MODE != 0) {
#pragma unroll
        for (int kk = 0; kk < 2; ++kk) {
#pragma unroll
            for (int dt = 0; dt < 4; ++dt) {
                const int drow = dt * 16 + fr;
                const bf16x8 vf = *(const bf16x8*)(Vt + drow * 128 + (((kk * 4 + fq) ^ ((drow >> 1) & 7)) << 4));
#pragma unroll
                for (int grp = 0; grp < 2; ++grp) o[grp][dt] = __builtin_amdgcn_mfma_f32_16x16x32_bf16(vf, pf[grp][kk], o[grp][dt], 0, 0, 0);
            }
        }
    }
}

template <int BR>
__device__ __forceinline__ void branch(const Stream& S, int& tau, int t0, int t1, int qt, const bf16x8 (&qf)[2][2], f32x4 (&o)[2][4], float (&m)[2], float (&lsum)[2],
                                       const float (&invl)[2], const int (&ql)[2], const int (&nmax)[2], const unsigned (&mlo)[2], const unsigned (&mhi)[2],
                                       float* impA, float* impB, int fr, int fq, int tid) {
#pragma unroll 1
    for (int t = t0; t < t1; ++t, ++tau) {
        if (tau + RD - 2 < S.ntot) asm volatile("s_waitcnt vmcnt(4)" ::: "memory"); else asm volatile("s_waitcnt vmcnt(0)" ::: "memory");
        __builtin_amdgcn_s_barrier();
        asm volatile("" ::: "memory");
        if (tau + RD - 1 < S.ntot) issue_tile(S, tau + RD - 1, tid);
        const unsigned char* Ks = dyn_lds + (tau & (RD - 1)) * SLOT;
        int lo[2], hi[2]; bool act[2];
        bool boundary;
        if (BR <= 1) boundary = true; else if (BR == 2) boundary = (t == qt); else boundary = (t == qt) || (t == qt - 8);
#pragma unroll
        for (int grp = 0; grp < 2; ++grp) {
            if (BR <= 1) { lo[grp] = 0; hi[grp] = nmax[grp] - 64 * t; act[grp] = true; }
            else if (BR == 2) { const unsigned bit = (t < 32) ? (mlo[grp] >> t) : (mhi[grp] >> (t - 32)); act[grp] = (bit & 1u) != 0; lo[grp] = 0; hi[grp] = act[grp] ? ql[grp] : -1; }
            else { act[grp] = true; lo[grp] = (t == qt - 8) ? ql[grp] + 1 : 0; hi[grp] = (t == qt) ? ql[grp] : 63; }
        }
        f32x4 s[2][4];
        constexpr int MD = (BR == 0) ? 0 : (BR == 1 ? 1 : 2);
        if (BR <= 1 || boundary) tile_compute<MD, true>(Ks, Ks + 8192, qf, o, m, lsum, invl, lo, hi, act, s, fr, fq);
        else tile_compute<MD, false>(Ks, Ks + 8192, qf, o, m, lsum, invl, lo, hi, act, s, fr, fq);
        if (BR == 1) {
#pragma unroll
            for (int grp = 0; grp < 2; ++grp)
#pragma unroll
                for (int kt = 0; kt < 4; ++kt) {
                    float a = (s[grp][kt][0] + s[grp][kt][1]) + (s[grp][kt][2] + 0.5f * s[grp][kt][3]), b2 = 0.5f * s[grp][kt][3];
                    a += shx(a, 1, fq * 16 + fr); a += shx(a, 2, fq * 16 + fr);
                    b2 += shx(b2, 1, fq * 16 + fr); b2 += shx(b2, 2, fq * 16 + fr);
                    if ((fr & 3) == 0) {
                        const int J = 16 * t + (kt >> 1) * 8 + fq * 2 + (kt & 1);
                        impA[ql[grp] * 64 + J] = a;
                        if (J + 1 < 64) impB[ql[grp] * 64 + J + 1] = b2;
                    }
                }
        }
    }
}

__device__ __forceinline__ void attn_unit(const Params& p, int l, int bg, int qt, int wv) {
    const int b = bg >> 1, g = bg & 1;
    const int tid = tidx(wv), wid = tid >> 6, lane = tid & 63, fr = lane & 15, fq = lane >> 4;
    float* impA = (float*)(dyn_lds + OFF_IMP);
    float* impB = impA + 4096;
    unsigned* selm = (unsigned*)(dyn_lds + OFF_SELM);
    f32x4* outa = (f32x4*)(dyn_lds + OFF_IMP) + tid;
    const bf16_t* proj = (const bf16_t*)(wsp(p) + WS_HP);
    bf16_t* mix = (bf16_t*)(wsp(p) + WS_MIX);
    const size_t tokb = (size_t)b * SEQ;
    Stream S;
    S.kcmp = (const bf16_t*)(wsp(p) + WS_KCMP) + ((size_t)(0 * 16 + bg) * 256) * 64;
    S.vcmpT = (const bf16_t*)(wsp(p) + WS_KCMP) + ((size_t)(1 * 16 + bg) * 256) * 64;
    S.ksel = proj + tokb * NPROJ + C_KS + g * 64; S.kwin = proj + tokb * NPROJ + C_KW + g * 64;
    S.vselT = (const bf16_t*)(wsp(p) + WS_VT) + ((size_t)(0 * 16 + bg) * 64) * SEQ;
    S.vwinT = (const bf16_t*)(wsp(p) + WS_VT) + ((size_t)(1 * 16 + bg) * 64) * SEQ;
    S.n0 = (qt >> 4) + 1; S.nsel = qt + 1; S.w0 = (qt >= 8) ? qt - 8 : 0; S.ntot = 2 * S.n0 + S.nsel + (qt - S.w0 + 1);
    __syncthreads();
#pragma unroll
    for (int i = 0; i < RD - 1; ++i) if (i < S.ntot) issue_tile(S, i, tid);
    const int r = fr & 3, head = g * 4 + r;
    int ql[2], nmax[2]; size_t qtok[2];
    bf16x8 qf[2][2];
    float gate[2][3];
#pragma unroll
    for (int grp = 0; grp < 2; ++grp) {
        ql[grp] = wid * 8 + grp * 4 + (fr >> 2);
        qtok[grp] = tokb + qt * 64 + ql[grp];
        nmax[grp] = (qt * 64 + ql[grp] - 31) >> 4;
        const bf16_t* qp = proj + qtok[grp] * NPROJ;
        qf[grp][0] = *(const bf16x8*)(qp + C_Q + head * 64 + fq * 8);
        qf[grp][1] = *(const bf16x8*)(qp + C_Q + head * 64 + 32 + fq * 8);
#pragma unroll
        for (int br = 0; br < 3; ++br) gate[grp][br] = sigmoidf_(bf2f(qp[C_GL + head * 3 + br]));
    }
    f32x4 o[2][4];
    float m[2], lsum[2], invl[2] = {0.f, 0.f};
    unsigned mlo[2] = {0u, 0u}, mhi[2] = {0u, 0u};
    int tau = 0;
#pragma unroll
    for (int grp = 0; grp < 2; ++grp) { m[grp] = NEGBIG; lsum[grp] = 0.f; }
    branch<0>(S, tau, 0, S.n0, qt, qf, o, m, lsum, invl, ql, nmax, mlo, mhi, impA, impB, fr, fq, tid);
#pragma unroll
    for (int grp = 0; grp < 2; ++grp) {
        float ls = lsum[grp]; ls += shx(ls, 16, fq * 16 + fr); ls += shx(ls, 32, fq * 16 + fr);
        invl[grp] = ls > 0.f ? fast_rcp(ls) : 0.f;
#pragma unroll
        for (int dt = 0; dt < 4; ++dt) o[grp][dt] = (f32x4){0.f, 0.f, 0.f, 0.f};
    }
    branch<1>(S, tau, 0, S.n0, qt, qf, o, m, lsum, invl, ql, nmax, mlo, mhi, impA, impB, fr, fq, tid);
    __syncthreads();
#pragma unroll 1
    for (int qi = 0; qi < 8; ++qi) {
        const int q = wid * 8 + qi, J = lane;
        const float v = impA[q * 64 + J] + (J > 0 ? impB[q * 64 + J] : 0.f);
        const bool valid = J <= qt, forced = (J == 0) || (J == qt) || (J == qt - 1);
        const float sc = forced ? 3e38f : (valid ? v : -3e38f);
        int rank = 0;
#pragma unroll
        for (int jj = 0; jj < 64; ++jj) {
            const float ov = __int_as_float(__builtin_amdgcn_readlane(__float_as_int(sc), jj));
            rank += ((ov > sc) || (ov == sc && jj < J)) ? 1 : 0;
        }
        const unsigned long long mk = __ballot((rank < 16) && valid);
        if (lane == 0) { selm[q * 2] = (unsigned)mk; selm[q * 2 + 1] = (unsigned)(mk >> 32); }
    }
    __syncthreads();
#pragma unroll
    for (int grp = 0; grp < 2; ++grp) {
        mlo[grp] = selm[ql[grp] * 2]; mhi[grp] = selm[ql[grp] * 2 + 1];
#pragma unroll
        for (int dt = 0; dt < 4; ++dt) outa[(grp * 4 + dt) * 512] = o[grp][dt] * gate[grp][0];
    }
#pragma unroll
    for (int grp = 0; grp < 2; ++grp) { m[grp] = NEGBIG; lsum[grp] = 0.f;
#pragma unroll
        for (int dt = 0; dt < 4; ++dt) o[grp][dt] = (f32x4){0.f, 0.f, 0.f, 0.f}; }
    branch<2>(S, tau, 0, qt + 1, qt, qf, o, m, lsum, invl, ql, nmax, mlo, mhi, impA, impB, fr, fq, tid);
#pragma unroll
    for (int grp = 0; grp < 2; ++grp) {
        float ls = lsum[grp]; ls += shx(ls, 16, fq * 16 + fr); ls += shx(ls, 32, fq * 16 + fr);
        const float sc2 = (ls > 0.f ? fast_rcp(ls) : 0.f) * gate[grp][1];
#pragma unroll
        for (int dt = 0; dt < 4; ++dt) { outa[(grp * 4 + dt) * 512] = outa[(grp * 4 + dt) * 512] + o[grp][dt] * sc2; o[grp][dt] = (f32x4){0.f, 0.f, 0.f, 0.f}; }
        m[grp] = NEGBIG; lsum[grp] = 0.f;
    }
    branch<3>(S, tau, S.w0, qt + 1, qt, qf, o, m, lsum, invl, ql, nmax, mlo, mhi, impA, impB, fr, fq, tid);
#pragma unroll
    for (int grp = 0; grp < 2; ++grp) {
        float ls = lsum[grp]; ls += shx(ls, 16, fq * 16 + fr); ls += shx(ls, 32, fq * 16 + fr);
        const float sc2 = (ls > 0.f ? fast_rcp(ls) : 0.f) * gate[grp][2];
#pragma unroll
        for (int dt = 0; dt < 4; ++dt) {
            const f32x4 v = outa[(grp * 4 + dt) * 512] + o[grp][dt] * sc2;
            u32x2 w; w.x = cvt_pk_bf16(v[0], v[1]); w.y = cvt_pk_bf16(v[2], v[3]);
            *(u32x2*)(mix + qtok[grp] * DM + 512 + head * 64 + dt * 16 + fq * 4) = w;
        }
    }
}

__device__ __forceinline__ void phase_attn(const Params& p, int l, int wv) {
    for (int u = bidx(); u < 1024; u += gdim()) {
        const int rnd = u >> 8, w = u & 255, bg = w >> 4, i = w & 15;
        const int qt = (rnd == 0) ? 63 - i : (rnd == 1) ? 32 + i : (rnd == 2) ? 31 - i : i;
        attn_unit(p, l, bg, qt, wv);
    }
    asm volatile("s_waitcnt vmcnt(0)" ::: "memory");
    __syncthreads();
}
}

#define XB_TMO      128
#define XB_XCNT(j)  (256  + 64 * (j))
#define XB_XSUB(j)  (1280 + 64 * (j))
#define XB_XGEN(j)  (2304 + 64 * (j))
#define XB_TOP      3328
#define XB_TOPGEN   3392
#define XCD_BAR_WORDS 3456
#define XB_SPIN_CAP (1u << 20)
#define LAS __attribute__((address_space(3)))
__device__ __forceinline__ unsigned xb_ld(unsigned* p)              { return __hip_atomic_load(p, __ATOMIC_RELAXED, __HIP_MEMORY_SCOPE_AGENT); }
__device__ __forceinline__ unsigned xb_add(unsigned* p, unsigned v) { return __hip_atomic_fetch_add(p, v, __ATOMIC_RELAXED, __HIP_MEMORY_SCOPE_AGENT); }
__device__ __forceinline__ unsigned xb_xcc_id() { return (unsigned)__builtin_amdgcn_s_getreg((3 << 11) | 20) & 0xFu; }
#define XB_SPIN(cond, bar) do { unsigned _sp = 0; while (cond) { __builtin_amdgcn_s_sleep(1); \
    if ((++_sp & 255u) == 0u) { if (xb_ld(&(bar)[XB_TMO])) break; if (_sp > XB_SPIN_CAP) { atomicAdd(&(bar)[XB_TMO], 1u); break; } } } } while (0)
struct XcdBarrier { unsigned* bar; unsigned x; volatile LAS unsigned* st; };
__device__ __forceinline__ XcdBarrier xcd_barrier_post(unsigned* bar, volatile LAS unsigned* st, int wv) {
    XcdBarrier b; b.bar = bar; b.x = xb_xcc_id(); b.st = st;
    if (tidx(wv) == 0) (void)xb_add(&bar[XB_XCNT(b.x)], 1u);
    return b;
}
__device__ __forceinline__ void xcd_barrier_complete(unsigned* bar, unsigned x, unsigned& nloc, unsigned& nx) {
    const unsigned G = gdim();
    unsigned sum, cnt, mine, sp = 0u;
    for (;;) {
        sum = 0u; cnt = 0u; mine = 0u;
#pragma unroll
        for (unsigned j = 0; j < 16; ++j) { const unsigned c = xb_ld(&bar[XB_XCNT(j)]); sum += c; cnt += (c > 0u) ? 1u : 0u; mine = (j == x) ? c : mine; }
        if (sum == G) break;
        __builtin_amdgcn_s_sleep(1);
        if ((++sp & 255u) == 0u) { if (xb_ld(&bar[XB_TMO])) break; if (sp > XB_SPIN_CAP) { atomicAdd(&bar[XB_TMO], 1u); break; } }
    }
    nloc = mine > 0u ? mine : 1u; nx = cnt > 0u ? cnt : 1u;
}
__device__ __forceinline__ void xcd_barrier(const XcdBarrier& b, int wv) {
    asm volatile("s_waitcnt vmcnt(0)" ::: "memory");
    __syncthreads();
    if (tidx(wv) == 0) {
        unsigned* bar = b.bar; asm volatile("" : "+s"(bar));
        __builtin_amdgcn_s_waitcnt(0);
        unsigned nloc = b.st[0], nx = b.st[1];
        if (nloc == 0u) { xcd_barrier_complete(bar, b.x, nloc, nx); b.st[0] = nloc; b.st[1] = nx; }
        const unsigned old = xb_add(&bar[XB_XSUB(b.x)], 1u);
        const unsigned gen = old / nloc;
        if (old + 1u == (gen + 1u) * nloc) {
            __builtin_amdgcn_fence(__ATOMIC_RELEASE, "agent");
            asm volatile("s_waitcnt vmcnt(0)" ::: "memory");
            const unsigned og = xb_add(&bar[XB_TOP], 1u);
            const unsigned tg = og / nx;
            if (og + 1u == (tg + 1u) * nx) xb_add(&bar[XB_TOPGEN], 1u);
            else XB_SPIN(xb_ld(&bar[XB_TOPGEN]) == tg, bar);
            __builtin_amdgcn_fence(__ATOMIC_ACQUIRE, "agent");
            xb_add(&bar[XB_XGEN(b.x)], 1u);
            asm volatile("s_waitcnt vmcnt(0)" ::: "memory");
        } else {
            XB_SPIN(xb_ld(&bar[XB_XGEN(b.x)]) == gen, bar);
            __builtin_amdgcn_fence(__ATOMIC_ACQUIRE, "agent");
            asm volatile("s_waitcnt vmcnt(0)" ::: "memory");
        }
    }
    __syncthreads();
}

constexpr int PH_PER_LAYER = 11, N_PHASES = 1 + 2 * PH_PER_LAYER;

__device__ __forceinline__ void phase_digest(const Params& p, int wv) {
    const bf16_t* mix = (const bf16_t*)(wsp(p) + WS_MIX); const bf16_t* kc = (const bf16_t*)(wsp(p) + WS_KCMP); const bf16_t* hp = (const bf16_t*)(wsp(p) + WS_HP);
    for (size_t i = (size_t)blockIdx.x * 512 + tidx(wv); i < (size_t)TOK * DM; i += (size_t)gridDim.x * 512) {
        const size_t row = i >> 10; const int col = (int)(i & 1023);
#if defined(MK_DIGEST) && MK_DIGEST == 1
        outp(p)[i] = (((MK_DSEL & 1) && col < 256) || ((MK_DSEL & 2) && col >= 256 && col < 512) ? bf2f(mix[i]) : 0.f) + ((MK_DSEL & 4) ? bf2f(kc[i & (2 * 16 * 256 * 64 - 1)]) : 0.f);
#else
        outp(p)[i] = bf2f(hp[row * NPROJ + col]) + bf2f(hp[row * NPROJ + 1024 + col]) + (col < 768 ? bf2f(hp[row * NPROJ + 2048 + col]) : 0.f);
#endif
    }
}
__device__ __forceinline__ void run_phase(const Params& p, const JobTab& jt, int ph, int wv) {
    if (ph == 99) { phase_digest(p, wv); return; }
#ifdef TEST_PH
    if (TEST_PH == 0) { phase_prologue(p, jt, wv); return; }
    const int l = (ph - 1) / PH_PER_LAYER, s = TEST_PH - 1;
#else
    if (ph == 0) { phase_prologue(p, jt, wv); return; }
    const int l = (ph - 1) / PH_PER_LAYER, s = (ph - 1) % PH_PER_LAYER;
#endif
    bf16_t* XB = (bf16_t*)(wsp(p) + WS_XB); bf16_t* HP = (bf16_t*)(wsp(p) + WS_HP); bf16_t* MIX = (bf16_t*)(wsp(p) + WS_MIX);
    switch (s) {
        case 0: case 8: {
            const bf16_t* W = (const bf16_t*)(wsp(p) + WS_GU + (size_t)(l * 2 + (s == 8)) * SZ_GU);
            gm::gemm_phase<5632, 1024>(XB, W, gm::EpiSwiglu{HP}, wv);
        } break;
        case 1: case 9: {
            const bf16_t* W = (const bf16_t*)(wsp(p) + WS_DN + (size_t)(l * 2 + (s == 9)) * SZ_DN);
            gm::gemm_phase<1024, 2816>(HP, W, gm::EpiResid{XB, outp(p), ALPHA, 0.5f}, wv);
        } break;
        case 2: phase_ln<false>(outp(p), XB, pin(p, 4) + l * DM, pin(p, 5) + l * DM, wv); break;
        case 3: gm::gemm_phase<NPROJ, 1024>(XB, (const bf16_t*)(wsp(p) + WS_IN + (size_t)l * SZ_IN), gm::EpiBf16{HP, NPROJ}, wv); break;
        case 4: phase_mixA(p, l, wv); break;
        case 5: at::phase_attn(p, l, wv); break;
        case 6: gm::gemm_phase<1024, 1024>(MIX, (const bf16_t*)(wsp(p) + WS_OUT + (size_t)l * SZ_OUT), gm::EpiResid{XB, outp(p), ALPHA, 1.0f}, wv); break;
        case 7: phase_ln<false>(outp(p), XB, pin(p, 21) + l * DM, pin(p, 22) + l * DM, wv); break;
        case 10: if (l == 0) phase_ln<false>(outp(p), XB, pin(p, 26), pin(p, 27), wv); else phase_ln<true>(outp(p), XB, pin(p, 26) + DM, pin(p, 27) + DM, wv); break;
    }
}

__global__ void __launch_bounds__(512, 2) fwd_megakernel(Params p, JobTab jt) {
    const int wv = __builtin_amdgcn_readfirstlane((int)(threadIdx.x >> 6));
#if MK_MULTI
    for (int ph = p.ph_lo; ph < p.ph_hi; ++ph) run_phase(p, jt, ph, wv);
#else
    cg::grid_group grid = cg::this_grid();
    volatile LAS unsigned* st = (volatile LAS unsigned*)(dyn_lds + XB_ST_OFF);
    if (tidx(wv) == 0) { st[0] = 0u; st[1] = 0u; }
    __syncthreads();
    XcdBarrier xb = xcd_barrier_post((unsigned*)(p.ws + WS_BAR), st, wv);
#pragma unroll 1
    for (int ph = p.ph_lo; ph < p.ph_hi; ++ph) {
        run_phase(p, jt, ph, wv);
        if (ph + 1 < p.ph_hi) { if (ph == 0) grid.sync(); else xcd_barrier(xb, wv); }
    }
#endif
}

extern "C" void kernel_launch(void* const* d_in, const int* in_sizes, int n_in, void* d_out, int out_size, void* d_ws, size_t ws_size, hipStream_t stream) {
    static int grid_blocks = 0;
    if (!grid_blocks) {
        int dev = 0, cus = 0, per_cu = 0;
        hipGetDevice(&dev);
        hipDeviceGetAttribute(&cus, hipDeviceAttributeMultiprocessorCount, dev);
        hipFuncSetAttribute((const void*)fwd_megakernel, hipFuncAttributeMaxDynamicSharedMemorySize, LDS_BYTES);
        hipOccupancyMaxActiveBlocksPerMultiprocessor(&per_cu, (const void*)fwd_megakernel, 512, LDS_BYTES);
        if (per_cu < 1) per_cu = 1;
        grid_blocks = cus * per_cu;
        if (ws_size < WS_END) fprintf(stderr, "kernel_launch: workspace too small (%zu < %zu)\n", ws_size, (size_t)WS_END);
    }
    Params p{};
    JobTab jt{};
    for (int i = 0; i < 28; ++i) p.in[i] = (const float*)d_in[i];
    p.out = (float*)d_out; p.ws = (unsigned char*)d_ws;
    {
        unsigned char* ws = (unsigned char*)d_ws;
        int nj = 0, tiles = 0;
        auto add = [&](const float* src, size_t dstoff, int K, int N, int Nsrc, int rowMul, int rowOff, int perm = 1) {
            TJob& j = jt.jobs[nj++]; j.perm = perm; j.pad = 0; j.src = src; j.dst = (bf16_t*)(ws + dstoff); j.K = K; j.N = N; j.Nsrc = Nsrc; j.rowMul = rowMul; j.rowOff = rowOff; j.tileStart = tiles;
            tiles += (K / 64) * (N / 64);
        };
        for (int l = 0; l < 2; ++l) {
            const size_t wgu = (size_t)l * 1024 * 2816, wdn = (size_t)l * 2816 * 1024;
            add(p.in[1] + wgu, WS_GU + (size_t)(l * 2 + 0) * SZ_GU, 1024, 2816, 2816, 256, 0);
            add(p.in[2] + wgu, WS_GU + (size_t)(l * 2 + 0) * SZ_GU, 1024, 2816, 2816, 256, 128);
            add(p.in[3] + wdn, WS_DN + (size_t)(l * 2 + 0) * SZ_DN, 2816, 1024, 1024, 128, 0);
            add(p.in[6] + (size_t)l * 1024 * NPROJ_SRC, WS_IN + (size_t)l * SZ_IN, 1024, 2816, NPROJ_SRC, 128, 0);
            add(p.in[20] + (size_t)l * 1024 * 1024, WS_OUT + (size_t)l * SZ_OUT, 1024, 1024, 1024, 128, 0);
            add(p.in[23] + wgu, WS_GU + (size_t)(l * 2 + 1) * SZ_GU, 1024, 2816, 2816, 256, 0);
            add(p.in[24] + wgu, WS_GU + (size_t)(l * 2 + 1) * SZ_GU, 1024, 2816, 2816, 256, 128);
            add(p.in[25] + wdn, WS_DN + (size_t)(l * 2 + 1) * SZ_DN, 2816, 1024, 1024, 128, 0);
            add(p.in[13] + (size_t)l * 2048 * 128, WS_C1 + (size_t)(l * 2 + 0) * 128 * 2048 * 2, 2048, 128, 128, 128, 0, 0);
            add(p.in[17] + (size_t)l * 2048 * 128, WS_C1 + (size_t)(l * 2 + 1) * 128 * 2048 * 2, 2048, 128, 128, 128, 0, 0);
            add(p.in[15] + (size_t)l * 128 * 64, WS_C2 + (size_t)(l * 2 + 0) * 64 * 128 * 2, 128, 64, 64, 128, 0, 0);
            add(p.in[19] + (size_t)l * 128 * 64, WS_C2 + (size_t)(l * 2 + 1) * 64 * 128 * 2, 128, 64, 64, 128, 0, 0);
        }
        p.ntiles_total = tiles;
    }
#if MK_MULTI
    for (int ph = 0; ph < (MK_STOP < N_PHASES ? MK_STOP : N_PHASES); ++ph) {
        p.ph_lo = ph; p.ph_hi = ph + 1;
        hipLaunchKernelGGL(fwd_megakernel, dim3(grid_blocks), dim3(512), LDS_BYTES, stream, p, jt);
    }
#ifdef MK_DIGEST
    p.ph_lo = 99; p.ph_hi = 100; hipLaunchKernelGGL(fwd_megakernel, dim3(grid_blocks), dim3(512), LDS_BYTES, stream, p, jt);
#endif
#else
    p.ph_lo = 0; p.ph_hi = (MK_STOP < N_PHASES ? MK_STOP : N_PHASES);
    (void)hipMemsetAsync((unsigned char*)d_ws + WS_BAR, 0, 16384, stream);
    void* args[] = {&p, &jt};
    hipError_t e = hipLaunchCooperativeKernel((const void*)fwd_megakernel, dim3(grid_blocks), dim3(512), args, LDS_BYTES, stream);
    if (e != hipSuccess) fprintf(stderr, "cooperative launch failed: %s (grid %d)\n", hipGetErrorString(e), grid_blocks);
#endif
}
```
